# Optimizing an MI355X kernel written in HIP

```python
import math
import jax, jax.numpy as jnp
from jax import lax
import numpy as np

D_MODEL = 1024
BATCH = 4
SEQ = 8192
DEPTH = 1

BRANCH_W = D_MODEL // 2
POOL_WINDOWS = (2, 4, 8, 16)
N_POOL_GROUPS = len(POOL_WINDOWS)
POOL_GROUP_W = BRANCH_W // N_POOL_GROUPS
DILATED_GROUPS = ((128, 1), (512, 4), (2048, 16))
N_ATT_GROUPS = len(DILATED_GROUPS)
HEAD_DIM = 64
HEADS_PER_GROUP = BRANCH_W // HEAD_DIM
N_ATT_HEADS = N_ATT_GROUPS * HEADS_PER_GROUP
QKV_W = N_ATT_HEADS * HEAD_DIM
Q_BLOCK = 128
NUM_BUCKETS = 32
MAX_DISTANCE = 1024
IN_W = 2 * BRANCH_W + 3 * QKV_W + BRANCH_W + 2 * D_MODEL
RMS_EPS = 1e-6
NEG_INF = -1e30

kernel_name = "hybrid_pool_dilated_attn_gated_block"


def _rmsnorm(x, g):
    xf = x.astype(jnp.float32)
    r = lax.rsqrt(jnp.mean(xf * xf, axis=-1, keepdims=True) + RMS_EPS)
    return (xf * r).astype(x.dtype) * g


def _t5_bucket(rel):
    nb = NUM_BUCKETS // 2
    ret = (rel > 0).astype(jnp.int32) * nb
    n = jnp.abs(rel)
    max_exact = nb // 2
    nf = jnp.maximum(n, 1).astype(jnp.float32)
    large = max_exact + (jnp.log(nf / max_exact) / math.log(MAX_DISTANCE / max_exact)
                         * (nb - max_exact)).astype(jnp.int32)
    large = jnp.minimum(large, nb - 1)
    return ret + jnp.where(n < max_exact, n, large)


def _multiscale_pool(u, w_pool, pool_scale):
    B, S, _ = u.shape
    ug = u.reshape(B, S, N_POOL_GROUPS, POOL_GROUP_W)
    cs = jnp.cumsum(ug.astype(jnp.float32), axis=1)
    cs = jnp.concatenate([jnp.zeros_like(cs[:, :1]), cs], axis=1)
    pos = jnp.arange(S, dtype=jnp.int32)[:, None]
    half = jnp.array([w // 2 for w in POOL_WINDOWS], dtype=jnp.int32)[None, :]
    lo = jnp.maximum(pos - half, 0)
    hi = jnp.minimum(pos + half - 1, S - 1)
    gidx = jnp.arange(N_POOL_GROUPS, dtype=jnp.int32)[None, :]
    win_sum = cs[:, hi + 1, gidx] - cs[:, lo, gidx]
    count = (hi - lo + 1).astype(jnp.float32)[None, :, :, None]
    pooled = (win_sum / count).astype(u.dtype) - ug
    mixed = jnp.einsum('bsgc,gcd->bsgd', pooled, w_pool)
    return mixed.reshape(B, S, BRANCH_W) * pool_scale


def _dilated_attention(q, k, v, rel_bias):
    B, S = q.shape[0], q.shape[1]
    n_blocks = S // Q_BLOCK
    scale = 1.0 / math.sqrt(HEAD_DIM)
    cfg = []
    for g, (window, dil) in enumerate(DILATED_GROUPS):
        n_side = window // (2 * dil)
        offs = jnp.arange(-n_side, n_side + 1, dtype=jnp.int32) * dil
        bias = rel_bias[_t5_bucket(offs)][:, g * HEADS_PER_GROUP:(g + 1) * HEADS_PER_GROUP]
        cfg.append((offs, bias.T.astype(jnp.float32), k[:, :, g], v[:, :, g]))

    def block(i):
        s0 = i * Q_BLOCK
        qpos = s0 + jnp.arange(Q_BLOCK, dtype=jnp.int32)
        qb = lax.dynamic_slice_in_dim(q, s0, Q_BLOCK, axis=1).astype(jnp.float32) * scale
        lses, outs = [], []
        for g, (offs, bias, kg_all, vg_all) in enumerate(cfg):
            nk = offs.shape[0]
            kpos = qpos[:, None] + offs[None, :]
            valid = (kpos >= 0) & (kpos < S)
            kidx = jnp.clip(kpos, 0, S - 1).reshape(-1)
            kg = jnp.take(kg_all, kidx, axis=1).reshape(B, Q_BLOCK, nk, HEADS_PER_GROUP, HEAD_DIM)
            vg = jnp.take(vg_all, kidx, axis=1).reshape(B, Q_BLOCK, nk, HEADS_PER_GROUP, HEAD_DIM)
            s = jnp.einsum('bqhd,bqkhd->bhqk', qb[:, :, g], kg.astype(jnp.float32))
            s = s + bias[None, :, None, :]
            s = jnp.where(valid[None, None], s, NEG_INF)
            lse = jax.nn.logsumexp(s, axis=-1)
            p = jnp.exp(s - lse[..., None])
            outs.append(jnp.einsum('bhqk,bqkhd->bqhd', p, vg.astype(jnp.float32)))
            lses.append(lse)
        wts = jax.nn.softmax(jnp.stack(lses, axis=0), axis=0)
        wts = jnp.transpose(wts, (0, 1, 3, 2))[..., None]
        out = jnp.sum(wts * jnp.stack(outs, axis=0), axis=0)
        return out.astype(q.dtype)

    o = lax.map(block, jnp.arange(n_blocks, dtype=jnp.int32))
    o = jnp.transpose(o, (1, 0, 2, 3, 4))
    return o.reshape(B, S, HEADS_PER_GROUP * HEAD_DIM)


def setup_inputs(seed: int = 0) -> dict:
    key = jax.random.key(seed)
    ks = jax.random.split(key, 12)
    f32 = jnp.float32
    x = jax.random.normal(ks[0], (BATCH, SEQ, D_MODEL), f32)
    norm_gain = 1.0 + 0.05 * jax.random.normal(ks[1], (DEPTH, D_MODEL), f32)
    w_in = jax.random.normal(ks[2], (DEPTH, D_MODEL, IN_W), f32) * D_MODEL ** -0.5
    b_gate = 0.01 * jax.random.normal(ks[3], (DEPTH, 2, D_MODEL), f32)
    rel_bias = 0.5 * jax.random.normal(ks[4], (NUM_BUCKETS, N_ATT_HEADS), f32)
    w_pool = jax.random.normal(ks[5], (DEPTH, N_POOL_GROUPS, POOL_GROUP_W, POOL_GROUP_W), f32) * POOL_GROUP_W ** -0.5
    pool_scale = 1.0 + 0.1 * jax.random.normal(ks[6], (DEPTH, BRANCH_W), f32)
    w_proj_a = jax.random.normal(ks[7], (DEPTH, BRANCH_W, D_MODEL), f32) * BRANCH_W ** -0.5
    w_proj_b = jax.random.normal(ks[8], (DEPTH, BRANCH_W, D_MODEL), f32) * BRANCH_W ** -0.5
    w_out = jax.random.normal(ks[9], (DEPTH, D_MODEL, D_MODEL), f32) * D_MODEL ** -0.5
    final_gain = 1.0 + 0.05 * jax.random.normal(ks[10], (D_MODEL,), f32)
    return {"x": x, "norm_gain": norm_gain, "w_in": w_in, "b_gate": b_gate,
            "rel_bias": rel_bias, "w_pool": w_pool, "pool_scale": pool_scale,
            "w_proj_a": w_proj_a, "w_proj_b": w_proj_b, "w_out": w_out,
            "final_gain": final_gain}


def reference(x, norm_gain, w_in, b_gate, rel_bias, w_pool, pool_scale,
              w_proj_a, w_proj_b, w_out, final_gain):
    B, S, D = x.shape
    splits = np.cumsum([BRANCH_W, BRANCH_W, QKV_W, QKV_W, QKV_W, BRANCH_W]).tolist()
    for l in range(DEPTH):
        h = _rmsnorm(x, norm_gain[l])
        z = h @ w_in[l]
        a_in, a_gate, q, k, v, b_gp, g_logits = jnp.split(z, splits, axis=-1)
        y_a = (_multiscale_pool(a_in, w_pool[l], pool_scale[l]) * jax.nn.silu(a_gate)) @ w_proj_a[l]
        shp = (B, S, N_ATT_GROUPS, HEADS_PER_GROUP, HEAD_DIM)
        att = _dilated_attention(q.reshape(shp), k.reshape(shp), v.reshape(shp), rel_bias)
        y_b = (att * jax.nn.silu(b_gp)) @ w_proj_b[l]
        gates = jax.nn.sigmoid(g_logits.reshape(B, S, 2, D) + b_gate[l])
        merged = gates[:, :, 0] * y_a + gates[:, :, 1] * y_b
        x = x + merged @ w_out[l]
    return _rmsnorm(x, final_gain)
```

```cpp
#include <hip/hip_runtime.h>
#include <cstdio>
#include <cstdint>
namespace pg8 {
#define PG8_LAS __attribute__((address_space(3)))
typedef unsigned short bf16_t;
typedef short bf16x8 __attribute__((ext_vector_type(8)));
typedef float f32x4 __attribute__((ext_vector_type(4)));
typedef unsigned u32x4 __attribute__((ext_vector_type(4)));
constexpr int BM = 256, BK = 64, HALF = 128, HTB = HALF * BK * 2  , STAGE_BYTES = 8 * HTB, NXCD = 8, WGM = 8;

__host__ __device__ __forceinline__ int lds_byte(int r, int c) { const int st = (r >> 4) * 2 + (c >> 5), rr = r & 15, cc = c & 31, ob = rr * 64 + cc * 2; return st * 1024 + (ob ^ (((ob >> 9) & 1) << 5)); }
__host__ __device__ __forceinline__ void stage_rc(int b, int& R, int& C) { const int st = b / 1024, sb = b % 1024, swz = sb ^ (((sb >> 9) & 1) << 5); R = (st >> 1) * 16 + swz / 64; C = (st & 1) * 32 + (swz % 64) / 2; }
__host__ __device__ __forceinline__ int perm32(int rho) { const int n = rho >> 4, i = rho & 15; return 8 * (i >> 2) + 4 * n + (i & 3); }

struct Unit { int pm, pn; };
struct Gemm { const bf16_t* A; const bf16_t* Bt; int M, N, K; };

struct StaticOrder {
    int nM, nN, nwg, G, c;
    __host__ __device__ void init(int M, int N, int G_, int c_) { nM = M / BM; nN = N / BM; nwg = nM * nN; G = G_; c = c_; }
    __host__ __device__ bool next(int i, Unit& u) const {
        const long L = (long)i * G + c; if (L >= nwg) return false;
        int wgid = (int)L; { const int q = nwg / NXCD, r = nwg % NXCD, xcd = wgid % NXCD, off = wgid / NXCD; wgid = (xcd < r ? xcd * (q + 1) : r * (q + 1) + (xcd - r) * q) + off; }
        const int nig = WGM * nN, gid = wgid / nig, fm = gid * WGM, gsz = (nM - fm) < WGM ? (nM - fm) : WGM;
        u.pm = fm + ((wgid % nig) % gsz); u.pn = (wgid % nig) / gsz; return true;
    }
    __device__ __forceinline__ void a_ready(const Unit&) const {}
    __device__ __forceinline__ void done(const Unit&) const {}
};
typedef float f32x2_t __attribute__((ext_vector_type(2))); typedef __bf16 bf16x2_t __attribute__((ext_vector_type(2)));
__device__ __forceinline__ unsigned cvt_pk_bf16(float lo, float hi) { f32x2_t v = {lo, hi}; bf16x2_t b = __builtin_convertvector(v, bf16x2_t); return __builtin_bit_cast(unsigned, b); }
__device__ __forceinline__ float bflo(unsigned w) { return __uint_as_float(w << 16); }
__device__ __forceinline__ float bfhi(unsigned w) { return __uint_as_float(w & 0xffff0000u); }
__device__ __forceinline__ float sigm(float x) { return __builtin_amdgcn_rcpf(1.0f + __builtin_amdgcn_exp2f(-1.4426950408889634f * x)); }
__device__ __forceinline__ u32x4 pack8(const f32x4 a, const f32x4 b) { u32x4 w; w.x = cvt_pk_bf16(a[0], a[1]); w.y = cvt_pk_bf16(a[2], a[3]); w.z = cvt_pk_bf16(b[0], b[1]); w.w = cvt_pk_bf16(b[2], b[3]); return w; }
__device__ __forceinline__ void unpack8(const u32x4 w, f32x4& a, f32x4& b) { a[0] = bflo(w.x); a[1] = bfhi(w.x); a[2] = bflo(w.y); a[3] = bfhi(w.y); b[0] = bflo(w.z); b[1] = bfhi(w.z); b[2] = bflo(w.w); b[3] = bfhi(w.w); }

struct EpiP1 {
    static constexpr bool PERM = true, AFTER_DRAIN = false;
    bf16_t* QKV; size_t tstride; bf16_t* AP; float qscale;
    __device__ __forceinline__ void operator()(const f32x4 (&acc)[2][2][4][2], const Unit& u, int wr, int wc, int fr, int fq) const {
        const int row0 = u.pm * BM + wr * 64 + fr;
        const bool isq = u.pn < 18; const int t = u.pn / 6;
        bf16_t* base = isq ? QKV + (size_t)t * tstride : AP;
        const int ldc = isq ? 1536 : 512, colt = isq ? (u.pn - 6 * t) * BM : (u.pn - 18) * BM;
        const float sc = (u.pn < 6) ? qscale : 1.f;
        const int col0 = colt + wc * 32 + 8 * fq;
#pragma unroll
        for (int ai = 0; ai < 2; ++ai)
#pragma unroll
            for (int m = 0; m < 4; ++m) { bf16_t* rowp = base + (size_t)(row0 + ai * HALF + m * 16) * ldc + col0;
#pragma unroll
                for (int bj = 0; bj < 2; ++bj) *(u32x4*)(rowp + bj * HALF) = pack8(acc[ai][bj][m][0] * sc, acc[ai][bj][m][1] * sc); }
    }
};
struct EpiP3 {
    static constexpr bool PERM = true, AFTER_DRAIN = false;
    const bf16_t* MIX; const bf16_t* ON; const float* LSE; const float* bgate; bf16_t* UA; bf16_t* UB; bf16_t* G;
    __device__ __forceinline__ void operator()(const f32x4 (&acc)[2][2][4][2], const Unit& u, int wr, int wc, int fr, int fq) const {
        const int row0 = u.pm * BM + wr * 64 + fr;
        if (u.pn < 2) {
            const int col0 = u.pn * BM + wc * 32 + 8 * fq;
#pragma unroll
            for (int ai = 0; ai < 2; ++ai)
#pragma unroll
                for (int m = 0; m < 4; ++m) { const size_t r = (size_t)(row0 + ai * HALF + m * 16);
#pragma unroll
                    for (int bj = 0; bj < 2; ++bj) { const int c = col0 + bj * HALF; f32x4 m0, m1; unpack8(*(const u32x4*)(MIX + r * 512 + c), m0, m1);
                        f32x4 v0 = acc[ai][bj][m][0], v1 = acc[ai][bj][m][1];
#pragma unroll
                        for (int i = 0; i < 4; ++i) { v0[i] = v0[i] * sigm(v0[i]) * m0[i]; v1[i] = v1[i] * sigm(v1[i]) * m1[i]; }
                        *(u32x4*)(UA + r * 512 + c) = pack8(v0, v1); } }
        } else if (u.pn < 4) {
            const int col0 = (u.pn - 2) * BM + wc * 32 + 8 * fq;
#pragma unroll
            for (int ai = 0; ai < 2; ++ai)
#pragma unroll
                for (int m = 0; m < 4; ++m) { const size_t r = (size_t)(row0 + ai * HALF + m * 16);
#pragma unroll
                    for (int bj = 0; bj < 2; ++bj) { const int c = col0 + bj * HALF, h = c >> 6;
                        const float l0 = LSE[r * 24 + h], l1 = LSE[r * 24 + 8 + h], l2 = LSE[r * 24 + 16 + h];
                        const float mx = fmaxf(fmaxf(l0, l1), l2);
                        float e0 = __builtin_amdgcn_exp2f(l0 - mx), e1 = __builtin_amdgcn_exp2f(l1 - mx), e2 = __builtin_amdgcn_exp2f(l2 - mx);
                        const float inv = __builtin_amdgcn_rcpf(e0 + e1 + e2); e0 *= inv; e1 *= inv; e2 *= inv;
                        f32x4 a0, a1, b0, b1, c0, c1;
                        unpack8(*(const u32x4*)(ON + r * 1536 + c), a0, a1); unpack8(*(const u32x4*)(ON + r * 1536 + 512 + c), b0, b1); unpack8(*(const u32x4*)(ON + r * 1536 + 1024 + c), c0, c1);
                        f32x4 v0 = acc[ai][bj][m][0], v1 = acc[ai][bj][m][1];
#pragma unroll
                        for (int i = 0; i < 4; ++i) { v0[i] = v0[i] * sigm(v0[i]) * (e0 * a0[i] + e1 * b0[i] + e2 * c0[i]); v1[i] = v1[i] * sigm(v1[i]) * (e0 * a1[i] + e1 * b1[i] + e2 * c1[i]); }
                        *(u32x4*)(UB + r * 512 + c) = pack8(v0, v1); } }
        } else {
            const int col0 = (u.pn - 4) * BM + wc * 32 + 8 * fq;
            f32x4 bv[2][2];
#pragma unroll
            for (int bj = 0; bj < 2; ++bj)
#pragma unroll
                for (int n = 0; n < 2; ++n) bv[bj][n] = *(const f32x4*)(bgate + col0 + bj * HALF + 4 * n);
#pragma unroll
            for (int ai = 0; ai < 2; ++ai)
#pragma unroll
                for (int m = 0; m < 4; ++m) { const size_t r = (size_t)(row0 + ai * HALF + m * 16);
#pragma unroll
                    for (int bj = 0; bj < 2; ++bj) { f32x4 v0 = acc[ai][bj][m][0] + bv[bj][0], v1 = acc[ai][bj][m][1] + bv[bj][1];
#pragma unroll
                        for (int i = 0; i < 4; ++i) { v0[i] = sigm(v0[i]); v1[i] = sigm(v1[i]); }
                        *(u32x4*)(G + r * 2048 + col0 + bj * HALF) = pack8(v0, v1); } }
        }
    }
};
template <bool SECOND> struct EpiP4 {
    static constexpr bool PERM = true, AFTER_DRAIN = false;
    const bf16_t* G; bf16_t* Y;
    __device__ __forceinline__ void operator()(const f32x4 (&acc)[2][2][4][2], const Unit& u, int wr, int wc, int fr, int fq) const {
        const int row0 = u.pm * BM + wr * 64 + fr, col0 = u.pn * BM + wc * 32 + 8 * fq;
#pragma unroll
        for (int ai = 0; ai < 2; ++ai)
#pragma unroll
            for (int m = 0; m < 4; ++m) { const size_t r = (size_t)(row0 + ai * HALF + m * 16);
#pragma unroll
                for (int bj = 0; bj < 2; ++bj) { const int c = col0 + bj * HALF; f32x4 g0, g1; unpack8(*(const u32x4*)(G + r * 2048 + (SECOND ? 1024 : 0) + c), g0, g1);
                    f32x4 v0 = acc[ai][bj][m][0] * g0, v1 = acc[ai][bj][m][1] * g1;
                    if (SECOND) { f32x4 y0, y1; unpack8(*(const u32x4*)(Y + r * 1024 + c), y0, y1); v0 += y0; v1 += y1; }
                    *(u32x4*)(Y + r * 1024 + c) = pack8(v0, v1); } }
    }
};
struct EpiP5 {
    static constexpr bool PERM = false, AFTER_DRAIN = false;
    const float* X; float* O;
    __device__ __forceinline__ void operator()(const f32x4 (&acc)[2][2][4][2], const Unit& u, int wr, int wc, int fr, int fq) const {
        const int row0 = u.pm * BM + wr * 64 + fr, col0 = u.pn * BM + wc * 32 + 4 * fq;
#pragma unroll
        for (int ai = 0; ai < 2; ++ai)
#pragma unroll
            for (int m = 0; m < 4; ++m) { const size_t r = (size_t)(row0 + ai * HALF + m * 16);
#pragma unroll
                for (int bj = 0; bj < 2; ++bj)
#pragma unroll
                    for (int n = 0; n < 2; ++n) { const size_t off = r * 1024 + col0 + bj * HALF + n * 16; *(f32x4*)(O + off) = *(const f32x4*)(X + off) + acc[ai][bj][m][n]; } }
    }
};

template <class Epi, class Sched, bool ALIGN_EPI = false, bool SP2 = false>
__device__ __forceinline__ void gemm_phase(PG8_LAS unsigned char* lds, const Gemm g, const Sched& S, const Epi& E) {
    const int tid = threadIdx.x, wid = __builtin_amdgcn_readfirstlane(tid >> 6), lane = tid & 63, wr = wid >> 2, wc = wid & 3, fr = lane & 15, fq = lane >> 4;
    const int K = g.K, nt = K / BK;
    unsigned voffA[2], voffB[2];
#pragma unroll
    for (int i = 0; i < 2; ++i) { int R, C; stage_rc(tid * 16 + i * 8192, R, C); const int Rb = Epi::PERM ? ((R & ~31) + perm32(R & 31)) : R;
        voffA[i] = (unsigned)(R * K + C) * 2u; voffB[i] = (unsigned)(Rb * K + C) * 2u; }
    const size_t kstep = (size_t)(BK * 2);
    const size_t hstep = (size_t)HALF * K * 2;
    const size_t tstep = 2 * hstep;
    const unsigned ldsw = (unsigned)wid * 1024u;
    const int aoff = lds_byte(wr * 64 + fr, fq * 8), boff = lds_byte(wc * 32 + fr, fq * 8);
#define PG8_SA(b, h) (((b) * 2 + (h)) * HTB)
#define PG8_SB(b, h) ((4 + (b) * 2 + (h)) * HTB)
#define PG8_STAGE(bufoff, gbase, voff) do { _Pragma("unroll") for (int _i = 0; _i < 2; ++_i) \
        __builtin_amdgcn_global_load_lds((const unsigned*)((const char*)(gbase) + (voff)[_i]), (PG8_LAS unsigned*)(lds + (bufoff) + ldsw + _i * 8192), 16, 0, 0); } while (0)
#define PG8_LDA(dst, b, h) do { _Pragma("unroll") for (int m = 0; m < 4; ++m) _Pragma("unroll") for (int k = 0; k < 2; ++k) dst[m][k] = *(const PG8_LAS bf16x8*)(lds + PG8_SA(b, h) + aoff + m * 2048 + k * 1024); } while (0)
#define PG8_LDB(dst, b, h) do { _Pragma("unroll") for (int n = 0; n < 2; ++n) _Pragma("unroll") for (int k = 0; k < 2; ++k) dst[n][k] = *(const PG8_LAS bf16x8*)(lds + PG8_SB(b, h) + boff + n * 2048 + k * 1024); } while (0)
#define PG8_MMA(ai, bj, At, Bt) do { __builtin_amdgcn_s_setprio(1); _Pragma("unroll") for (int m = 0; m < 4; ++m) _Pragma("unroll") for (int n = 0; n < 2; ++n) _Pragma("unroll") for (int k = 0; k < 2; ++k) \
        acc[ai][bj][m][n] = __builtin_amdgcn_mfma_f32_16x16x32_bf16(Bt[n][k], At[m][k], acc[ai][bj][m][n], 0, 0, 0); __builtin_amdgcn_s_setprio(0); } while (0)
#define PG8_WAIT_V(n) asm volatile("s_waitcnt vmcnt(" #n ")" ::: "memory")
#define PG8_WAIT_L(n) asm volatile("s_waitcnt lgkmcnt(" #n ")" ::: "memory")
#define PG8_BAR __builtin_amdgcn_s_barrier()
#define PG8_SCHED __builtin_amdgcn_sched_barrier(0)
    Unit cur, nxt; int ui = 0;
    if (!S.next(0, cur)) return;
    f32x4 acc[2][2][4][2];
#pragma unroll
    for (int a = 0; a < 2; ++a)
#pragma unroll
        for (int b = 0; b < 2; ++b)
#pragma unroll
            for (int m = 0; m < 4; ++m)
#pragma unroll
                for (int n = 0; n < 2; ++n) acc[a][b][m][n] = (f32x4){0.f, 0.f, 0.f, 0.f};
    bf16x8 At[4][2], B0[2][2], B1[2][2];
    const char* cA = (const char*)g.A + (size_t)cur.pm * tstep; const char* cB = (const char*)g.Bt + (size_t)cur.pn * tstep;
    S.a_ready(cur);
    if constexpr (SP2) {
        PG8_STAGE(PG8_SB(0, 0), cB, voffB); PG8_STAGE(PG8_SB(0, 1), cB + hstep, voffB); PG8_STAGE(PG8_SA(0, 0), cA, voffA); PG8_STAGE(PG8_SA(0, 1), cA + hstep, voffA);
        if (wr == 1) PG8_BAR;
        PG8_WAIT_V(2); PG8_BAR;
        PG8_STAGE(PG8_SB(1, 0), cB + kstep, voffB); PG8_STAGE(PG8_SA(1, 0), cA + kstep, voffA); PG8_STAGE(PG8_SB(1, 1), cB + hstep + kstep, voffB);
        PG8_WAIT_V(6); PG8_BAR;
    } else {
        PG8_STAGE(PG8_SB(0, 0), cB, voffB); PG8_STAGE(PG8_SA(0, 0), cA, voffA); PG8_STAGE(PG8_SB(0, 1), cB + hstep, voffB); PG8_STAGE(PG8_SA(0, 1), cA + hstep, voffA);
        if (wr == 1) PG8_BAR;
        PG8_WAIT_V(4); PG8_BAR;
        PG8_STAGE(PG8_SB(1, 0), cB + kstep, voffB); PG8_STAGE(PG8_SA(1, 0), cA + kstep, voffA); PG8_STAGE(PG8_SB(1, 1), cB + hstep + kstep, voffB);
        PG8_WAIT_V(6); PG8_BAR;
    }
    for (;;) {
        const bool has_next = S.next(ui + 1, nxt);
        const char* nA = has_next ? (const char*)g.A + (size_t)nxt.pm * tstep : cA; const char* nB = has_next ? (const char*)g.Bt + (size_t)nxt.pn * tstep : cB;
        for (int t = 0; t < nt; t += 2) {
            const bool last = (t == nt - 2);
            const char* a1 = cA + (size_t)(t + 1) * kstep;
            const char* a2 = last ? nA : cA + (size_t)(t + 2) * kstep; const char* b2 = last ? nB : cB + (size_t)(t + 2) * kstep;
            const char* a3 = a2 + kstep; const char* b3 = b2 + kstep;
            if (last && has_next) S.a_ready(nxt);
            if constexpr (SP2) {
            PG8_LDB(B0, 0, 0); PG8_LDB(B1, 0, 1); PG8_SCHED; PG8_LDA(At, 0, 0); PG8_STAGE(PG8_SA(1, 1), a1 + hstep, voffA);
            PG8_WAIT_V(8); PG8_WAIT_L(0); PG8_BAR; PG8_MMA(0, 0, At, B0); PG8_MMA(0, 1, At, B1); PG8_BAR; PG8_SCHED;
            PG8_LDA(At, 0, 1); PG8_STAGE(PG8_SB(0, 0), b2, voffB); PG8_STAGE(PG8_SB(0, 1), b2 + hstep, voffB); PG8_STAGE(PG8_SA(0, 0), a2, voffA);
            PG8_WAIT_V(8); PG8_WAIT_L(0); PG8_BAR; PG8_MMA(1, 0, At, B0); PG8_MMA(1, 1, At, B1); PG8_BAR; PG8_SCHED;
            PG8_LDB(B0, 1, 0); PG8_LDB(B1, 1, 1); PG8_SCHED; PG8_LDA(At, 1, 0); PG8_STAGE(PG8_SA(0, 1), a2 + hstep, voffA);
            PG8_WAIT_V(8); PG8_WAIT_L(0); PG8_BAR; PG8_MMA(0, 0, At, B0); PG8_MMA(0, 1, At, B1); PG8_BAR; PG8_SCHED;
            PG8_LDA(At, 1, 1); PG8_STAGE(PG8_SB(1, 0), b3, voffB); PG8_STAGE(PG8_SB(1, 1), b3 + hstep, voffB); PG8_STAGE(PG8_SA(1, 0), a3, voffA);
            PG8_WAIT_V(8); PG8_WAIT_L(0); PG8_BAR; PG8_MMA(1, 0, At, B0); PG8_MMA(1, 1, At, B1); PG8_BAR; PG8_SCHED;
            } else {
            PG8_LDB(B0, 0, 0); PG8_SCHED; PG8_LDA(At, 0, 0); PG8_STAGE(PG8_SA(1, 1), a1 + hstep, voffA);
            PG8_WAIT_L(8); PG8_BAR; PG8_WAIT_L(0); PG8_MMA(0, 0, At, B0); PG8_BAR; PG8_SCHED;
            PG8_LDB(B1, 0, 1); PG8_STAGE(PG8_SB(0, 0), b2, voffB);
            PG8_BAR; PG8_WAIT_L(0); PG8_MMA(0, 1, At, B1); PG8_BAR;
            PG8_LDA(At, 0, 1); PG8_STAGE(PG8_SA(0, 0), a2, voffA);
            PG8_BAR; PG8_WAIT_L(0); PG8_MMA(1, 0, At, B0); PG8_BAR; PG8_SCHED;
            PG8_STAGE(PG8_SB(0, 1), b2 + hstep, voffB);
            PG8_WAIT_V(6); PG8_BAR; PG8_MMA(1, 1, At, B1); PG8_BAR;
            PG8_LDB(B0, 1, 0); PG8_SCHED; PG8_LDA(At, 1, 0); PG8_STAGE(PG8_SA(0, 1), a2 + hstep, voffA);
            PG8_WAIT_L(8); PG8_BAR; PG8_WAIT_L(0); PG8_MMA(0, 0, At, B0); PG8_BAR; PG8_SCHED;
            PG8_LDB(B1, 1, 1); PG8_STAGE(PG8_SB(1, 0), b3, voffB);
            PG8_BAR; PG8_WAIT_L(0); PG8_MMA(0, 1, At, B1); PG8_BAR;
            PG8_LDA(At, 1, 1); PG8_STAGE(PG8_SA(1, 0), a3, voffA);
            PG8_BAR; PG8_WAIT_L(0); PG8_MMA(1, 0, At, B0); PG8_BAR; PG8_SCHED;
            PG8_STAGE(PG8_SB(1, 1), b3 + hstep, voffB);
            PG8_WAIT_V(6); PG8_BAR; PG8_MMA(1, 1, At, B1); PG8_BAR;
            }
        }
        if constexpr (ALIGN_EPI) { if (wr == 0) PG8_BAR; }
        if constexpr (!Epi::AFTER_DRAIN) { E(acc, cur, wr, wc, fr, fq); S.done(cur); }
        if (!has_next) break;
#pragma unroll
        for (int a = 0; a < 2; ++a)
#pragma unroll
            for (int b = 0; b < 2; ++b)
#pragma unroll
                for (int m = 0; m < 4; ++m)
#pragma unroll
                    for (int n = 0; n < 2; ++n) acc[a][b][m][n] = (f32x4){0.f, 0.f, 0.f, 0.f};
        cur = nxt; cA = nA; cB = nB; ++ui;
        if constexpr (ALIGN_EPI) { if (wr == 1) PG8_BAR; }
    }
    PG8_WAIT_V(0);
    if constexpr (!ALIGN_EPI) { if (wr == 0) PG8_BAR; }
    PG8_BAR;
    if constexpr (Epi::AFTER_DRAIN) { E.fused(acc, cur, wr, wc, fr, fq, lds, wid, lane); S.done(cur); }
#undef PG8_SA
#undef PG8_SB
#undef PG8_STAGE
#undef PG8_LDA
#undef PG8_LDB
#undef PG8_MMA
#undef PG8_WAIT_V
#undef PG8_WAIT_L
#undef PG8_BAR
#undef PG8_SCHED
}
}

constexpr int NWAVES = 8;
constexpr int BATCH = 4, SEQ = 8192, D = 1024, M = BATCH * SEQ;
constexpr int BW = 512, NQKV = 4608, N1 = 5120, N2 = 3072, INW = 8192, QKVP = 1536, NGH = 24, NKEY = 129, BIASP = 132;
constexpr float RMS_EPS = 1e-6f;
constexpr float LOG2E = 1.4426950408889634f;
constexpr float C2 = 0.125f * LOG2E;
#ifndef MK_ONE_LAUNCH
#define MK_ONE_LAUNCH 0
#endif
constexpr int NPHASE = 7;

constexpr size_t MiB = 1u << 20;
constexpr size_t WS_CTL = 0, CTL_ZERO_BYTES = 1 * MiB;
constexpr size_t WS_WT1 = 2 * MiB;
constexpr size_t WS_WT2 = 12 * MiB;
constexpr size_t WS_WAT = 18 * MiB, WS_WBT = 19 * MiB, WS_WOT = 20 * MiB;
constexpr size_t WS_BIAS = 22 * MiB;
constexpr size_t WS_LSE = 23 * MiB;
constexpr size_t WS_Q = 32 * MiB, WS_K = 128 * MiB, WS_V = 224 * MiB;
constexpr size_t WS_AP = 320 * MiB;
constexpr size_t WS_MIX = 352 * MiB;
constexpr size_t WS_XN = 384 * MiB;
constexpr size_t WS_UA = 128 * MiB, WS_UB = 160 * MiB, WS_G = 192 * MiB;
constexpr size_t WS_MRG = 320 * MiB;
constexpr size_t WS_END = 448 * MiB;
constexpr int CW_BAR = 4096;

constexpr int RING_OFF = 0, RING_BYTES = 131072;
constexpr int LDSCTL_OFF = RING_BYTES, MISC_OFF = LDSCTL_OFF + 320;
constexpr int LDS_BYTES = 147456;

static_assert(WS_V - WS_K == WS_K - WS_Q, "Q|K|V equally spaced");
#define GAS __attribute__((address_space(1)))
#define LAS __attribute__((address_space(3)))
typedef unsigned short bf16;
typedef unsigned v4u __attribute__((ext_vector_type(4)));
typedef float f32x4 __attribute__((ext_vector_type(4)));
typedef short bf16x8 __attribute__((ext_vector_type(8)));
typedef GAS unsigned gu32;
typedef GAS unsigned long long gu64;
#define RLX_AGENT __ATOMIC_RELAXED, __HIP_MEMORY_SCOPE_AGENT
#define LDS_WAIT() asm volatile("s_waitcnt lgkmcnt(0)" ::: "memory")
#define VM_WAIT() asm volatile("s_waitcnt vmcnt(0)" ::: "memory")
__device__ __forceinline__ unsigned long long rt() { return __builtin_amdgcn_s_memrealtime(); }
__device__ __forceinline__ unsigned f2bf(float f) { unsigned u = __builtin_bit_cast(unsigned, f); return (u + 0x7fffu + ((u >> 16) & 1u)) >> 16; }
__device__ __forceinline__ unsigned pk2(float lo, float hi) { return f2bf(lo) | (f2bf(hi) << 16); }

#define XB_TMO      128
#define XB_XCNT(j)  (256  + 64 * (j))
#define XB_XSUB(j)  (1280 + 64 * (j))
#define XB_XGEN(j)  (2304 + 64 * (j))
#define XB_TOP      3328
#define XB_TOPGEN   3392
#define XCD_BAR_WORDS 3456
#define XB_SPIN_CAP (1u << 18)

__device__ __forceinline__ unsigned xb_ld(unsigned* p)              { return __hip_atomic_load(p, __ATOMIC_RELAXED, __HIP_MEMORY_SCOPE_AGENT); }
__device__ __forceinline__ unsigned xb_add(unsigned* p, unsigned v) { return __hip_atomic_fetch_add(p, v, __ATOMIC_RELAXED, __HIP_MEMORY_SCOPE_AGENT); }
__device__ __forceinline__ unsigned xb_xcc_id() { return (unsigned)__builtin_amdgcn_s_getreg((3 << 11) | 20) & 0xFu; }
#define XB_SPIN(cond, bar) do { unsigned _sp = 0; while (cond) { __builtin_amdgcn_s_sleep(1); \
    if ((++_sp & 255u) == 0u) { if (xb_ld(&(bar)[XB_TMO])) break; if (_sp > XB_SPIN_CAP) { atomicAdd(&(bar)[XB_TMO], 1u); break; } } } } while (0)

struct XcdBarrier {
    unsigned* bar; unsigned x;
    volatile LAS unsigned* st;
};

__device__ __forceinline__ XcdBarrier xcd_barrier_post(unsigned* bar, volatile LAS unsigned* st) {
    XcdBarrier b; b.bar = bar; b.x = xb_xcc_id(); b.st = st;
    if (threadIdx.x == 0) (void)xb_add(&bar[XB_XCNT(b.x)], 1u);
    return b;
}
__device__ __forceinline__ void xcd_barrier_complete(unsigned* bar, unsigned x, unsigned& nloc, unsigned& nx) {
    const unsigned G = gridDim.x * gridDim.y * gridDim.z;
    unsigned sum, cnt, mine, sp = 0u;
    for (;;) {
        sum = 0u; cnt = 0u; mine = 0u;
#pragma unroll
        for (unsigned j = 0; j < 16; ++j) { const unsigned c = xb_ld(&bar[XB_XCNT(j)]); sum += c; cnt += (c > 0u) ? 1u : 0u; mine = (j == x) ? c : mine; }
        if (sum == G) break;
        __builtin_amdgcn_s_sleep(1);
        if ((++sp & 255u) == 0u) { if (xb_ld(&bar[XB_TMO])) break; if (sp > XB_SPIN_CAP) { atomicAdd(&bar[XB_TMO], 1u); break; } }
    }
    nloc = mine > 0u ? mine : 1u; nx = cnt > 0u ? cnt : 1u;
}

__device__ __forceinline__ void xcd_barrier(const XcdBarrier& b) {
    asm volatile("s_waitcnt vmcnt(0)" ::: "memory");
    __syncthreads();
    if (threadIdx.x == 0) {
        unsigned* bar = b.bar;
        __builtin_amdgcn_s_waitcnt(0);
        unsigned nloc = b.st[0], nx = b.st[1];
        if (nloc == 0u) { xcd_barrier_complete(bar, b.x, nloc, nx); b.st[0] = nloc; b.st[1] = nx; }
        const unsigned old = xb_add(&bar[XB_XSUB(b.x)], 1u);
        const unsigned gen = old / nloc;
        if (old + 1u == (gen + 1u) * nloc) {
            __builtin_amdgcn_fence(__ATOMIC_RELEASE, "agent");
            asm volatile("s_waitcnt vmcnt(0)" ::: "memory");
            const unsigned og = xb_add(&bar[XB_TOP], 1u);
            const unsigned tg = og / nx;
            if (og + 1u == (tg + 1u) * nx) xb_add(&bar[XB_TOPGEN], 1u);
            else XB_SPIN(xb_ld(&bar[XB_TOPGEN]) == tg, bar);
            __builtin_amdgcn_fence(__ATOMIC_ACQUIRE, "agent");
            xb_add(&bar[XB_XGEN(b.x)], 1u);
            asm volatile("s_waitcnt vmcnt(0)" ::: "memory");
        } else {
            XB_SPIN(xb_ld(&bar[XB_XGEN(b.x)]) == gen, bar);
            __builtin_amdgcn_fence(__ATOMIC_ACQUIRE, "agent");
            asm volatile("s_waitcnt vmcnt(0)" ::: "memory");
        }
    }
    __syncthreads();
}

struct Frame {
    LAS unsigned char* lds;
    int tid, lane, wave;
    int vcu, G;
    const float *x, *norm_gain, *w_in, *b_gate, *rel_bias, *w_pool, *pool_scale, *w_proj_a, *w_proj_b, *w_out, *final_gain;
    float* out;
    bf16 *Wt1, *Wt2, *Wat, *Wbt, *Wot;
    float *BIAS, *LSE;
    bf16 *Qb, *Kb, *Vb, *AP, *MIX, *XN, *UA, *UB, *GG, *MRG;
};
__device__ __forceinline__ float wave_sum(float v) {
#pragma unroll
    for (int o = 1; o < 64; o <<= 1) v += __shfl_xor(v, o);
    return v;
}
__device__ __forceinline__ float wave_max(float v) {
#pragma unroll
    for (int o = 1; o < 64; o <<= 1) v = fmaxf(v, __shfl_xor(v, o));
    return v;
}
__device__ __forceinline__ float bf2f(unsigned short b) { return __uint_as_float(((unsigned)b) << 16); }
__device__ __forceinline__ float blo(unsigned w) { return __uint_as_float(w << 16); }
__device__ __forceinline__ float bhi(unsigned w) { return __uint_as_float(w & 0xffff0000u); }

__device__ __forceinline__ void p0_transpose_item(const float* W, int ldw, int col0, int ncols, int K, const float* gain, bf16* WT, int row_off, LAS float* scr, int item, int lane) {
    const int nblk = ncols / 32, kb = item / nblk, nb = item % nblk, k0 = 64 * kb, n0 = 32 * nb;
#pragma unroll 8
    for (int i = 0; i < 32; ++i) { const int kk = 2 * i + (lane >> 5); float v = W[(size_t)(k0 + kk) * ldw + col0 + n0 + (lane & 31)]; if (gain) v *= gain[k0 + kk]; scr[kk * 33 + (lane & 31)] = v; }
    LDS_WAIT(); asm volatile("" ::: "memory");
    const int c = lane & 7;
#pragma unroll
    for (int j = 0; j < 4; ++j) { const int n = (lane >> 3) + 8 * j; const LAS float* s = scr + (8 * c) * 33 + n;
        v4u o; o.x = pk2(s[0 * 33], s[1 * 33]); o.y = pk2(s[2 * 33], s[3 * 33]); o.z = pk2(s[4 * 33], s[5 * 33]); o.w = pk2(s[6 * 33], s[7 * 33]);
        *(GAS v4u*)(WT + (size_t)(row_off + n0 + n) * K + k0 + 8 * c) = o; }
    LDS_WAIT(); asm volatile("" ::: "memory");
}
__device__ __forceinline__ void rms_row_to_bf16(const float* xrow, bf16* orow, int lane) {
    const GAS f32x4* xr = (const GAS f32x4*)xrow + lane;
    f32x4 v[4]; float s = 0.f;
#pragma unroll
    for (int j = 0; j < 4; ++j) { v[j] = xr[64 * j]; s += (v[j].x * v[j].x + v[j].y * v[j].y) + (v[j].z * v[j].z + v[j].w * v[j].w); }
    const float r = 1.0f / sqrtf(wave_sum(s) * (1.f / D) + RMS_EPS);
    GAS unsigned long long* o8 = (GAS unsigned long long*)orow + lane;
#pragma unroll
    for (int j = 0; j < 4; ++j) o8[64 * j] = (unsigned long long)pk2(v[j].x * r, v[j].y * r) | ((unsigned long long)pk2(v[j].z * r, v[j].w * r) << 32);
}
__device__ __forceinline__ int t5_bucket(int rel) {
    const int nb = 16, max_exact = 8;
    const int ret = (rel > 0) ? nb : 0;
    const int n = rel < 0 ? -rel : rel;
    const float nf = (float)(n > 1 ? n : 1);
    int large = max_exact + (int)(logf(nf / (float)max_exact) / logf(1024.0f / (float)max_exact) * (float)(nb - max_exact));
    large = large < nb - 1 ? large : nb - 1;
    return ret + (n < max_exact ? n : large);
}
__device__ __forceinline__ void p0_prologue(Frame& F) {
    {
        LAS float* tile = (LAS float*)(F.lds + RING_OFF);
        for (int task = F.vcu; task < 16 * 4 * 4; task += F.G) {
            const int kb = task >> 4, gp = (task >> 2) & 3, dq = task & 3;
            __syncthreads();
#pragma unroll
            for (int i = 0; i < 16; ++i) { const int e = F.tid + 512 * i, kk = e >> 7, c = e & 127; tile[kk * 129 + c] = F.w_in[(size_t)(kb * 64 + kk) * INW + gp * 128 + c]; }
            __syncthreads();
            const int k = kb * 64 + F.lane; float a[4] = {0.f, 0.f, 0.f, 0.f}; const int d0 = dq * 32 + F.wave * 4;
            const float* wp = F.w_pool + (size_t)gp * 16384 + d0;
            for (int c = 0; c < 128; ++c) { const float t = tile[F.lane * 129 + c];
#pragma unroll
                for (int i = 0; i < 4; ++i) a[i] += t * wp[c * 128 + i]; }
            const float gk = F.norm_gain[k];
#pragma unroll
            for (int i = 0; i < 4; ++i) { const int cp = gp * 128 + d0 + i; F.Wt1[(size_t)(NQKV + cp) * D + k] = (bf16)f2bf(a[i] * gk * F.pool_scale[cp]); }
        }
        __syncthreads();
    }
    LAS float* scr = (LAS float*)(F.lds + RING_OFF + F.wave * 16384);
    const int gw = F.vcu * NWAVES + F.wave, NGW = F.G * NWAVES;
    constexpr int I_QKV = (D / 64) * (NQKV / 32), I_AG = (D / 64) * (BW / 32), I_GL = (D / 64) * (2 * D / 32), I_PA = (BW / 64) * (D / 32), I_WO = (D / 64) * (D / 32);
    constexpr int NITEMS = I_QKV + 2 * I_AG + I_GL + 2 * I_PA + I_WO;
    for (int it = gw; it < NITEMS; it += NGW) {
        int r = it;
        if (r < I_QKV) { p0_transpose_item(F.w_in, INW, 1024, NQKV, D, F.norm_gain, F.Wt1, 0, scr, r, F.lane); continue; } r -= I_QKV;
        if (r < I_AG)  { p0_transpose_item(F.w_in, INW, 512, BW, D, F.norm_gain, F.Wt2, 0, scr, r, F.lane); continue; } r -= I_AG;
        if (r < I_AG)  { p0_transpose_item(F.w_in, INW, 5632, BW, D, F.norm_gain, F.Wt2, 512, scr, r, F.lane); continue; } r -= I_AG;
        if (r < I_GL)  { p0_transpose_item(F.w_in, INW, 6144, 2 * D, D, F.norm_gain, F.Wt2, 1024, scr, r, F.lane); continue; } r -= I_GL;
        if (r < I_PA)  { p0_transpose_item(F.w_proj_a, D, 0, D, BW, nullptr, F.Wat, 0, scr, r, F.lane); continue; } r -= I_PA;
        if (r < I_PA)  { p0_transpose_item(F.w_proj_b, D, 0, D, BW, nullptr, F.Wbt, 0, scr, r, F.lane); continue; } r -= I_PA;
        p0_transpose_item(F.w_out, D, 0, D, D, nullptr, F.Wot, 0, scr, r, F.lane);
    }
    for (int m = gw; m < M; m += NGW) rms_row_to_bf16(F.x + (size_t)m * D, F.XN + (size_t)m * D, F.lane);
    for (int idx = (int)blockIdx.x * 512 + F.tid; idx < NGH * BIASP; idx += F.G * 512) {
        const int gh = idx / BIASP, j = idx % BIASP, g = gh >> 3; const int dil = (g == 0) ? 1 : ((g == 1) ? 4 : 16);
        float v = 0.f; if (j < NKEY) v = F.rel_bias[t5_bucket((j - 64) * dil) * NGH + gh] * LOG2E;
        F.BIAS[idx] = v;
    }
}

__device__ __forceinline__ void p2_attention_simple(Frame& F) {
    LAS float* pbuf = (LAS float*)(F.lds + RING_OFF + F.wave * 1024);
    const int gw = F.vcu * NWAVES + F.wave, NGW = F.G * NWAVES, lane = F.lane;
    for (int task = gw; task < M * NGH; task += NGW) {
        const int t = task / NGH, gh = task - t * NGH, g = gh >> 3, h = gh & 7;
        const int pos = t & (SEQ - 1), dil = (g == 0) ? 1 : ((g == 1) ? 4 : 16);
        const size_t hoff = (size_t)g * 512 + h * 64;
        bf16* qrow = F.Qb + (size_t)t * QKVP + hoff;
        float q[64];
#pragma unroll
        for (int i = 0; i < 8; ++i) { const v4u w = *(const GAS v4u*)(qrow + 8 * i);
            q[8 * i + 0] = blo(w.x); q[8 * i + 1] = bhi(w.x); q[8 * i + 2] = blo(w.y); q[8 * i + 3] = bhi(w.y); q[8 * i + 4] = blo(w.z); q[8 * i + 5] = bhi(w.z); q[8 * i + 6] = blo(w.w); q[8 * i + 7] = bhi(w.w); }
        float s[3];
#pragma unroll
        for (int jj = 0; jj < 3; ++jj) {
            const int j = lane + 64 * jj, kpos = pos + (j - 64) * dil; const bool valid = (j < NKEY) && (kpos >= 0) && (kpos < SEQ);
            float dot = -INFINITY;
            if (valid) { const bf16* krow = F.Kb + (size_t)(t - pos + kpos) * QKVP + hoff; dot = 0.f;
#pragma unroll
                for (int i = 0; i < 8; ++i) { const v4u w = *(const GAS v4u*)(krow + 8 * i);
                    dot += q[8 * i + 0] * blo(w.x) + q[8 * i + 1] * bhi(w.x) + q[8 * i + 2] * blo(w.y) + q[8 * i + 3] * bhi(w.y) + q[8 * i + 4] * blo(w.z) + q[8 * i + 5] * bhi(w.z) + q[8 * i + 6] * blo(w.w) + q[8 * i + 7] * bhi(w.w); }
                dot += F.BIAS[gh * BIASP + j]; }
            s[jj] = dot;
        }
        const float mx = wave_max(fmaxf(fmaxf(s[0], s[1]), s[2]));
        float lsum = 0.f;
#pragma unroll
        for (int jj = 0; jj < 3; ++jj) { const float p = __builtin_amdgcn_exp2f(s[jj] - mx); pbuf[lane + 64 * jj] = p; lsum += p; }
        lsum = wave_sum(lsum);
        LDS_WAIT(); asm volatile("" ::: "memory");
        float o = 0.f;
        for (int j = 0; j < NKEY; ++j) { const int kpos = pos + (j - 64) * dil;
            if (kpos >= 0 && kpos < SEQ) o += pbuf[j] * bf2f(F.Vb[(size_t)(t - pos + kpos) * QKVP + hoff + lane]); }
        LDS_WAIT(); asm volatile("" ::: "memory");
        qrow[lane] = (bf16)f2bf(o / lsum);
        if (lane == 0) F.LSE[(size_t)t * NGH + gh] = mx + log2f(lsum);
    }
}
__device__ __forceinline__ void p2_pool(Frame& F) {
    const int gw = F.vcu * NWAVES + F.wave, NGW = F.G * NWAVES, lane = F.lane;
    const int half = 1 << (lane >> 4);
    for (int t = gw; t < M; t += NGW) {
        const int pos = t & (SEQ - 1);
        const bf16* base = F.AP + (size_t)(t - pos) * BW + lane * 8;
        float acc[8] = {0.f, 0.f, 0.f, 0.f, 0.f, 0.f, 0.f, 0.f}; int cnt = 0;
#pragma unroll
        for (int j = 0; j < 16; ++j) { const int row = pos - half + j;
            if (j < 2 * half && row >= 0 && row < SEQ) { const v4u w = *(const GAS v4u*)(base + (size_t)row * BW); ++cnt;
                acc[0] += blo(w.x); acc[1] += bhi(w.x); acc[2] += blo(w.y); acc[3] += bhi(w.y); acc[4] += blo(w.z); acc[5] += bhi(w.z); acc[6] += blo(w.w); acc[7] += bhi(w.w); } }
        const v4u cw = *(const GAS v4u*)(base + (size_t)pos * BW); const float fc = (float)cnt;
        v4u o; o.x = pk2(acc[0] / fc - blo(cw.x), acc[1] / fc - bhi(cw.x)); o.y = pk2(acc[2] / fc - blo(cw.y), acc[3] / fc - bhi(cw.y));
        o.z = pk2(acc[4] / fc - blo(cw.z), acc[5] / fc - bhi(cw.z)); o.w = pk2(acc[6] / fc - blo(cw.w), acc[7] / fc - bhi(cw.w));
        *(GAS v4u*)(F.MIX + (size_t)t * BW + lane * 8) = o;
    }
}
__device__ __forceinline__ void p6_final_norm(Frame& F) {
    const int gw = F.vcu * NWAVES + F.wave, NGW = F.G * NWAVES, lane = F.lane;
    f32x4 gn[4];
#pragma unroll
    for (int j = 0; j < 4; ++j) gn[j] = ((const GAS f32x4*)F.final_gain)[lane + 64 * j];
    for (int m = gw; m < M; m += NGW) {
        GAS f32x4* yr = (GAS f32x4*)(F.out + (size_t)m * D) + lane;
        f32x4 v[4]; float s = 0.f;
#pragma unroll
        for (int j = 0; j < 4; ++j) { v[j] = yr[64 * j]; s += (v[j].x * v[j].x + v[j].y * v[j].y) + (v[j].z * v[j].z + v[j].w * v[j].w); }
        const float r = 1.0f / sqrtf(wave_sum(s) * (1.f / D) + RMS_EPS);
#pragma unroll
        for (int j = 0; j < 4; ++j) yr[64 * j] = v[j] * r * gn[j];
    }
}

struct Args { const float* in[11]; float* out; unsigned char* ws; int ph_lo, ph_hi; };
__global__ void __launch_bounds__(NWAVES * 64, 2) skel_fwd(Args args) {
    extern __shared__ __attribute__((aligned(16))) unsigned char lds[];
    Frame F;
    F.lds = (LAS unsigned char*)lds;
    F.tid = threadIdx.x; F.lane = F.tid & 63; F.wave = __builtin_amdgcn_readfirstlane(F.tid >> 6);
    F.G = gridDim.x; { const int bx = blockIdx.x; F.vcu = (F.G % 8 == 0) ? (bx % 8) * (F.G / 8) + bx / 8 : bx; }
    unsigned char* ws = args.ws;
    F.x = args.in[0]; F.norm_gain = args.in[1]; F.w_in = args.in[2]; F.b_gate = args.in[3]; F.rel_bias = args.in[4]; F.w_pool = args.in[5]; F.pool_scale = args.in[6];
    F.w_proj_a = args.in[7]; F.w_proj_b = args.in[8]; F.w_out = args.in[9]; F.final_gain = args.in[10]; F.out = args.out;
    F.Wt1 = (bf16*)(ws + WS_WT1); F.Wt2 = (bf16*)(ws + WS_WT2); F.Wat = (bf16*)(ws + WS_WAT); F.Wbt = (bf16*)(ws + WS_WBT); F.Wot = (bf16*)(ws + WS_WOT);
    F.BIAS = (float*)(ws + WS_BIAS); F.LSE = (float*)(ws + WS_LSE);
    F.Qb = (bf16*)(ws + WS_Q); F.Kb = (bf16*)(ws + WS_K); F.Vb = (bf16*)(ws + WS_V); F.AP = (bf16*)(ws + WS_AP); F.MIX = (bf16*)(ws + WS_MIX); F.XN = (bf16*)(ws + WS_XN);
    F.UA = (bf16*)(ws + WS_UA); F.UB = (bf16*)(ws + WS_UB); F.GG = (bf16*)(ws + WS_G); F.MRG = (bf16*)(ws + WS_MRG);
    for (int u = F.tid; u < (LDS_BYTES - LDSCTL_OFF) / 4; u += NWAVES * 64) ((LAS unsigned*)(F.lds + LDSCTL_OFF))[u] = 0u;
    __syncthreads();
    const int lo = args.ph_lo, hi = args.ph_hi;
    XcdBarrier bar; bar.bar = (unsigned*)(ws + WS_CTL) + CW_BAR; bar.x = 0; bar.st = nullptr;
    if (hi - lo > 1) bar = xcd_barrier_post((unsigned*)(ws + WS_CTL) + CW_BAR, (volatile LAS unsigned*)(F.lds + MISC_OFF) + 8);
#define IN(k) (lo <= (k) && (k) < hi)
#define SEAM(k) do { if (IN(k) && IN((k) + 1)) xcd_barrier(bar); } while (0)

    if (IN(0)) { p0_prologue(F); SEAM(0); }
    if (IN(1)) {
        pg8::Gemm g{F.XN, F.Wt1, M, N1, D}; pg8::StaticOrder S; S.init(M, N1, F.G, (int)blockIdx.x);
        pg8::EpiP1 E{F.Qb, (size_t)(WS_K - WS_Q) / 2, F.AP, C2};
        pg8::gemm_phase<pg8::EpiP1, pg8::StaticOrder, true, true>(F.lds + RING_OFF, g, S, E);
        SEAM(1);
    }
    if (IN(2)) { p2_attention_simple(F); p2_pool(F); SEAM(2); }
    if (IN(3)) {
        pg8::Gemm g{F.XN, F.Wt2, M, N2, D}; pg8::StaticOrder S; S.init(M, N2, F.G, (int)blockIdx.x);
        pg8::EpiP3 E{F.MIX, F.Qb, F.LSE, F.b_gate, F.UA, F.UB, F.GG};
        pg8::gemm_phase<pg8::EpiP3, pg8::StaticOrder, true, true>(F.lds + RING_OFF, g, S, E);
        SEAM(3);
    }
    if (IN(4)) {
        { pg8::Gemm g{F.UA, F.Wat, M, D, BW}; pg8::StaticOrder S; S.init(M, D, F.G, (int)blockIdx.x);
          pg8::EpiP4<false> E{F.GG, F.MRG};
          pg8::gemm_phase<pg8::EpiP4<false>, pg8::StaticOrder, true, true>(F.lds + RING_OFF, g, S, E); }
        { pg8::Gemm g{F.UB, F.Wbt, M, D, BW}; pg8::StaticOrder S; S.init(M, D, F.G, (int)blockIdx.x);
          pg8::EpiP4<true> E{F.GG, F.MRG};
          pg8::gemm_phase<pg8::EpiP4<true>, pg8::StaticOrder, true, true>(F.lds + RING_OFF, g, S, E); }
        SEAM(4);
    }
    if (IN(5)) {
        pg8::Gemm g{F.MRG, F.Wot, M, D, D}; pg8::StaticOrder S; S.init(M, D, F.G, (int)blockIdx.x);
        pg8::EpiP5 E{F.x, F.out};
        pg8::gemm_phase<pg8::EpiP5, pg8::StaticOrder, true, true>(F.lds + RING_OFF, g, S, E);
        SEAM(5);
    }
    if (IN(6)) { p6_final_norm(F); }
#undef IN
#undef SEAM
}

extern "C" void kernel_launch(void* const* d_in, const int* in_sizes, int n_in, void* d_out, int out_size, void* d_ws, size_t ws_size, hipStream_t stream) {
    static int grid = 0;
    if (grid == 0) {
        if (n_in != 11 || in_sizes[0] != M * D || out_size != M * D || ws_size < WS_END) { fprintf(stderr, "kernel_launch: unexpected shapes (n_in %d, in0 %d, out %d, ws %zu); nothing launched\n", n_in, n_in > 0 ? in_sizes[0] : -1, out_size, ws_size); grid = -1; return; }
        int dev = 0, cus = 0, per_cu = 0;
        if (hipGetDevice(&dev) != hipSuccess || hipDeviceGetAttribute(&cus, hipDeviceAttributeMultiprocessorCount, dev) != hipSuccess) { grid = -1; return; }
        if (hipFuncSetAttribute((const void*)skel_fwd, hipFuncAttributeMaxDynamicSharedMemorySize, LDS_BYTES) != hipSuccess) { fprintf(stderr, "kernel_launch: hipFuncSetAttribute failed\n"); grid = -1; return; }
        if (hipOccupancyMaxActiveBlocksPerMultiprocessor(&per_cu, (const void*)skel_fwd, NWAVES * 64, LDS_BYTES) != hipSuccess || per_cu < 1) { fprintf(stderr, "kernel_launch: occupancy query reports %d\n", per_cu); }
        (void)hipGetLastError();
        grid = cus;
    }
    if (grid < 0) return;
    if (hipMemsetAsync((char*)d_ws + WS_CTL, 0, CTL_ZERO_BYTES, stream) != hipSuccess) return;
    Args a{};
    for (int i = 0; i < 11; ++i) a.in[i] = (const float*)d_in[i];
    a.out = (float*)d_out; a.ws = (unsigned char*)d_ws;
#if MK_ONE_LAUNCH
    a.ph_lo = 0; a.ph_hi = NPHASE;
    hipLaunchKernelGGL(skel_fwd, dim3(grid), dim3(NWAVES * 64), LDS_BYTES, stream, a);
#else
    for (int p = 0; p < NPHASE; ++p) { a.ph_lo = p; a.ph_hi = p + 1; hipLaunchKernelGGL(skel_fwd, dim3(grid), dim3(NWAVES * 64), LDS_BYTES, stream, a); }
#endif
}
```

```cpp
#include <hip/hip_runtime.h>
#include <cstdio>
#include <cstdint>
namespace pg8 {
#define PG8_LAS __attribute__((address_space(3)))
typedef unsigned short bf16_t;
typedef short bf16x8 __attribute__((ext_vector_type(8)));
typedef float f32x4 __attribute__((ext_vector_type(4)));
typedef unsigned u32x4 __attribute__((ext_vector_type(4)));
constexpr int BM = 256, BK = 64, HALF = 128, HTB = HALF * BK * 2  , STAGE_BYTES = 8 * HTB, NXCD = 8, WGM = 8;

__host__ __device__ __forceinline__ int lds_byte(int r, int c) { const int st = (r >> 4) * 2 + (c >> 5), rr = r & 15, cc = c & 31, ob = rr * 64 + cc * 2; return st * 1024 + (ob ^ (((ob >> 9) & 1) << 5)); }
__host__ __device__ __forceinline__ void stage_rc(int b, int& R, int& C) { const int st = b / 1024, sb = b % 1024, swz = sb ^ (((sb >> 9) & 1) << 5); R = (st >> 1) * 16 + swz / 64; C = (st & 1) * 32 + (swz % 64) / 2; }
__host__ __device__ __forceinline__ int perm32(int rho) { const int n = rho >> 4, i = rho & 15; return 8 * (i >> 2) + 4 * n + (i & 3); }

struct Unit { int pm, pn; };
struct Gemm { const bf16_t* A; const bf16_t* Bt; int M, N, K; };

struct StaticOrder {
    int nM, nN, nwg, G, c;
    __host__ __device__ void init(int M, int N, int G_, int c_) { nM = M / BM; nN = N / BM; nwg = nM * nN; G = G_; c = c_; }
    __host__ __device__ bool next(int i, Unit& u) const {
        const long L = (long)i * G + c; if (L >= nwg) return false;
        int wgid = (int)L; { const int q = nwg / NXCD, r = nwg % NXCD, xcd = wgid % NXCD, off = wgid / NXCD; wgid = (xcd < r ? xcd * (q + 1) : r * (q + 1) + (xcd - r) * q) + off; }
        const int nig = WGM * nN, gid = wgid / nig, fm = gid * WGM, gsz = (nM - fm) < WGM ? (nM - fm) : WGM;
        u.pm = fm + ((wgid % nig) % gsz); u.pn = (wgid % nig) / gsz; return true;
    }
    __device__ __forceinline__ void a_ready(const Unit&) const {}
    __device__ __forceinline__ void done(const Unit&) const {}
};
typedef float f32x2_t __attribute__((ext_vector_type(2))); typedef __bf16 bf16x2_t __attribute__((ext_vector_type(2)));
__device__ __forceinline__ unsigned cvt_pk_bf16(float lo, float hi) { f32x2_t v = {lo, hi}; bf16x2_t b = __builtin_convertvector(v, bf16x2_t); return __builtin_bit_cast(unsigned, b); }
__device__ __forceinline__ float bflo(unsigned w) { return __uint_as_float(w << 16); }
__device__ __forceinline__ float bfhi(unsigned w) { return __uint_as_float(w & 0xffff0000u); }
__device__ __forceinline__ float sigm(float x) { return __builtin_amdgcn_rcpf(1.0f + __builtin_amdgcn_exp2f(-1.4426950408889634f * x)); }
__device__ __forceinline__ u32x4 pack8(const f32x4 a, const f32x4 b) { u32x4 w; w.x = cvt_pk_bf16(a[0], a[1]); w.y = cvt_pk_bf16(a[2], a[3]); w.z = cvt_pk_bf16(b[0], b[1]); w.w = cvt_pk_bf16(b[2], b[3]); return w; }
__device__ __forceinline__ void unpack8(const u32x4 w, f32x4& a, f32x4& b) { a[0] = bflo(w.x); a[1] = bfhi(w.x); a[2] = bflo(w.y); a[3] = bfhi(w.y); b[0] = bflo(w.z); b[1] = bfhi(w.z); b[2] = bflo(w.w); b[3] = bfhi(w.w); }

struct EpiP1 {
    static constexpr bool PERM = true, AFTER_DRAIN = false;
    bf16_t* QKV; size_t tstride; bf16_t* AP; float qscale;
    __device__ __forceinline__ void operator()(const f32x4 (&acc)[2][2][4][2], const Unit& u, int wr, int wc, int fr, int fq) const {
        const int row0 = u.pm * BM + wr * 64 + fr;
        const bool isq = u.pn < 18; const int t = u.pn / 6;
        bf16_t* base = isq ? QKV + (size_t)t * tstride : AP;
        const int ldc = isq ? 1536 : 512, colt = isq ? (u.pn - 6 * t) * BM : (u.pn - 18) * BM;
        const float sc = (u.pn < 6) ? qscale : 1.f;
        const int col0 = colt + wc * 32 + 8 * fq;
#pragma unroll
        for (int ai = 0; ai < 2; ++ai)
#pragma unroll
            for (int m = 0; m < 4; ++m) { bf16_t* rowp = base + (size_t)(row0 + ai * HALF + m * 16) * ldc + col0;
#pragma unroll
                for (int bj = 0; bj < 2; ++bj) *(u32x4*)(rowp + bj * HALF) = pack8(acc[ai][bj][m][0] * sc, acc[ai][bj][m][1] * sc); }
    }
};
struct EpiP3 {
    static constexpr bool PERM = true, AFTER_DRAIN = false;
    const bf16_t* MIX; const bf16_t* ON; const float* LSE; const float* bgate; bf16_t* UA; bf16_t* UB; bf16_t* G;
    __device__ __forceinline__ void operator()(const f32x4 (&acc)[2][2][4][2], const Unit& u, int wr, int wc, int fr, int fq) const {
        const int row0 = u.pm * BM + wr * 64 + fr;
        if (u.pn < 2) {
            const int col0 = u.pn * BM + wc * 32 + 8 * fq;
#pragma unroll
            for (int ai = 0; ai < 2; ++ai)
#pragma unroll
                for (int m = 0; m < 4; ++m) { const size_t r = (size_t)(row0 + ai * HALF + m * 16);
#pragma unroll
                    for (int bj = 0; bj < 2; ++bj) { const int c = col0 + bj * HALF; f32x4 m0, m1; unpack8(*(const u32x4*)(MIX + r * 512 + c), m0, m1);
                        f32x4 v0 = acc[ai][bj][m][0], v1 = acc[ai][bj][m][1];
#pragma unroll
                        for (int i = 0; i < 4; ++i) { v0[i] = v0[i] * sigm(v0[i]) * m0[i]; v1[i] = v1[i] * sigm(v1[i]) * m1[i]; }
                        *(u32x4*)(UA + r * 512 + c) = pack8(v0, v1); } }
        } else if (u.pn < 4) {
            const int col0 = (u.pn - 2) * BM + wc * 32 + 8 * fq;
#pragma unroll
            for (int ai = 0; ai < 2; ++ai)
#pragma unroll
                for (int m = 0; m < 4; ++m) { const size_t r = (size_t)(row0 + ai * HALF + m * 16);
#pragma unroll
                    for (int bj = 0; bj < 2; ++bj) { const int c = col0 + bj * HALF, h = c >> 6;
                        const float l0 = LSE[r * 24 + h], l1 = LSE[r * 24 + 8 + h], l2 = LSE[r * 24 + 16 + h];
                        const float mx = fmaxf(fmaxf(l0, l1), l2);
                        float e0 = __builtin_amdgcn_exp2f(l0 - mx), e1 = __builtin_amdgcn_exp2f(l1 - mx), e2 = __builtin_amdgcn_exp2f(l2 - mx);
                        const float inv = __builtin_amdgcn_rcpf(e0 + e1 + e2); e0 *= inv; e1 *= inv; e2 *= inv;
                        f32x4 a0, a1, b0, b1, c0, c1;
                        unpack8(*(const u32x4*)(ON + r * 1536 + c), a0, a1); unpack8(*(const u32x4*)(ON + r * 1536 + 512 + c), b0, b1); unpack8(*(const u32x4*)(ON + r * 1536 + 1024 + c), c0, c1);
                        f32x4 v0 = acc[ai][bj][m][0], v1 = acc[ai][bj][m][1];
#pragma unroll
                        for (int i = 0; i < 4; ++i) { v0[i] = v0[i] * sigm(v0[i]) * (e0 * a0[i] + e1 * b0[i] + e2 * c0[i]); v1[i] = v1[i] * sigm(v1[i]) * (e0 * a1[i] + e1 * b1[i] + e2 * c1[i]); }
                        *(u32x4*)(UB + r * 512 + c) = pack8(v0, v1); } }
        } else {
            const int col0 = (u.pn - 4) * BM + wc * 32 + 8 * fq;
            f32x4 bv[2][2];
#pragma unroll
            for (int bj = 0; bj < 2; ++bj)
#pragma unroll
                for (int n = 0; n < 2; ++n) bv[bj][n] = *(const f32x4*)(bgate + col0 + bj * HALF + 4 * n);
#pragma unroll
            for (int ai = 0; ai < 2; ++ai)
#pragma unroll
                for (int m = 0; m < 4; ++m) { const size_t r = (size_t)(row0 + ai * HALF + m * 16);
#pragma unroll
                    for (int bj = 0; bj < 2; ++bj) { f32x4 v0 = acc[ai][bj][m][0] + bv[bj][0], v1 = acc[ai][bj][m][1] + bv[bj][1];
#pragma unroll
                        for (int i = 0; i < 4; ++i) { v0[i] = sigm(v0[i]); v1[i] = sigm(v1[i]); }
                        *(u32x4*)(G + r * 2048 + col0 + bj * HALF) = pack8(v0, v1); } }
        }
    }
};
template <bool SECOND> struct EpiP4 {
    static constexpr bool PERM = true, AFTER_DRAIN = false;
    const bf16_t* G; bf16_t* Y;
    __device__ __forceinline__ void operator()(const f32x4 (&acc)[2][2][4][2], const Unit& u, int wr, int wc, int fr, int fq) const {
        const int row0 = u.pm * BM + wr * 64 + fr, col0 = u.pn * BM + wc * 32 + 8 * fq;
#pragma unroll
        for (int ai = 0; ai < 2; ++ai)
#pragma unroll
            for (int m = 0; m < 4; ++m) { const size_t r = (size_t)(row0 + ai * HALF + m * 16);
#pragma unroll
                for (int bj = 0; bj < 2; ++bj) { const int c = col0 + bj * HALF; f32x4 g0, g1; unpack8(*(const u32x4*)(G + r * 2048 + (SECOND ? 1024 : 0) + c), g0, g1);
                    f32x4 v0 = acc[ai][bj][m][0] * g0, v1 = acc[ai][bj][m][1] * g1;
                    if (SECOND) { f32x4 y0, y1; unpack8(*(const u32x4*)(Y + r * 1024 + c), y0, y1); v0 += y0; v1 += y1; }
                    *(u32x4*)(Y + r * 1024 + c) = pack8(v0, v1); } }
    }
};
struct EpiP5 {
    static constexpr bool PERM = false, AFTER_DRAIN = false;
    const float* X; float* O;
    __device__ __forceinline__ void operator()(const f32x4 (&acc)[2][2][4][2], const Unit& u, int wr, int wc, int fr, int fq) const {
        const int row0 = u.pm * BM + wr * 64 + fr, col0 = u.pn * BM + wc * 32 + 4 * fq;
#pragma unroll
        for (int ai = 0; ai < 2; ++ai)
#pragma unroll
            for (int m = 0; m < 4; ++m) { const size_t r = (size_t)(row0 + ai * HALF + m * 16);
#pragma unroll
                for (int bj = 0; bj < 2; ++bj)
#pragma unroll
                    for (int n = 0; n < 2; ++n) { const size_t off = r * 1024 + col0 + bj * HALF + n * 16; *(f32x4*)(O + off) = *(const f32x4*)(X + off) + acc[ai][bj][m][n]; } }
    }
};

template <class Epi, class Sched, bool ALIGN_EPI = false, bool SP2 = false>
__device__ __forceinline__ void gemm_phase(PG8_LAS unsigned char* lds, const Gemm g, const Sched& S, const Epi& E) {
    const int tid = threadIdx.x, wid = __builtin_amdgcn_readfirstlane(tid >> 6), lane = tid & 63, wr = wid >> 2, wc = wid & 3, fr = lane & 15, fq = lane >> 4;
    const int K = g.K, nt = K / BK;
    unsigned voffA[2], voffB[2];
#pragma unroll
    for (int i = 0; i < 2; ++i) { int R, C; stage_rc(tid * 16 + i * 8192, R, C); const int Rb = Epi::PERM ? ((R & ~31) + perm32(R & 31)) : R;
        voffA[i] = (unsigned)(R * K + C) * 2u; voffB[i] = (unsigned)(Rb * K + C) * 2u; }
    const size_t kstep = (size_t)(BK * 2);
    const size_t hstep = (size_t)HALF * K * 2;
    const size_t tstep = 2 * hstep;
    const unsigned ldsw = (unsigned)wid * 1024u;
    const int aoff = lds_byte(wr * 64 + fr, fq * 8), boff = lds_byte(wc * 32 + fr, fq * 8);
#define PG8_SA(b, h) (((b) * 2 + (h)) * HTB)
#define PG8_SB(b, h) ((4 + (b) * 2 + (h)) * HTB)
#define PG8_STAGE(bufoff, gbase, voff) do { _Pragma("unroll") for (int _i = 0; _i < 2; ++_i) \
        __builtin_amdgcn_global_load_lds((const unsigned*)((const char*)(gbase) + (voff)[_i]), (PG8_LAS unsigned*)(lds + (bufoff) + ldsw + _i * 8192), 16, 0, 0); } while (0)
#define PG8_LDA(dst, b, h) do { _Pragma("unroll") for (int m = 0; m < 4; ++m) _Pragma("unroll") for (int k = 0; k < 2; ++k) dst[m][k] = *(const PG8_LAS bf16x8*)(lds + PG8_SA(b, h) + aoff + m * 2048 + k * 1024); } while (0)
#define PG8_LDB(dst, b, h) do { _Pragma("unroll") for (int n = 0; n < 2; ++n) _Pragma("unroll") for (int k = 0; k < 2; ++k) dst[n][k] = *(const PG8_LAS bf16x8*)(lds + PG8_SB(b, h) + boff + n * 2048 + k * 1024); } while (0)
#define PG8_MMA(ai, bj, At, Bt) do { __builtin_amdgcn_s_setprio(1); _Pragma("unroll") for (int m = 0; m < 4; ++m) _Pragma("unroll") for (int n = 0; n < 2; ++n) _Pragma("unroll") for (int k = 0; k < 2; ++k) \
        acc[ai][bj][m][n] = __builtin_amdgcn_mfma_f32_16x16x32_bf16(Bt[n][k], At[m][k], acc[ai][bj][m][n], 0, 0, 0); __builtin_amdgcn_s_setprio(0); } while (0)
#define PG8_WAIT_V(n) asm volatile("s_waitcnt vmcnt(" #n ")" ::: "memory")
#define PG8_WAIT_L(n) asm volatile("s_waitcnt lgkmcnt(" #n ")" ::: "memory")
#define PG8_BAR __builtin_amdgcn_s_barrier()
#define PG8_SCHED __builtin_amdgcn_sched_barrier(0)
    Unit cur, nxt; int ui = 0;
    if (!S.next(0, cur)) return;
    f32x4 acc[2][2][4][2];
#pragma unroll
    for (int a = 0; a < 2; ++a)
#pragma unroll
        for (int b = 0; b < 2; ++b)
#pragma unroll
            for (int m = 0; m < 4; ++m)
#pragma unroll
                for (int n = 0; n < 2; ++n) acc[a][b][m][n] = (f32x4){0.f, 0.f, 0.f, 0.f};
    bf16x8 At[4][2], B0[2][2], B1[2][2];
    const char* cA = (const char*)g.A + (size_t)cur.pm * tstep; const char* cB = (const char*)g.Bt + (size_t)cur.pn * tstep;
    S.a_ready(cur);
    if constexpr (SP2) {
        PG8_STAGE(PG8_SB(0, 0), cB, voffB); PG8_STAGE(PG8_SB(0, 1), cB + hstep, voffB); PG8_STAGE(PG8_SA(0, 0), cA, voffA); PG8_STAGE(PG8_SA(0, 1), cA + hstep, voffA);
        if (wr == 1) PG8_BAR;
        PG8_WAIT_V(2); PG8_BAR;
        PG8_STAGE(PG8_SB(1, 0), cB + kstep, voffB); PG8_STAGE(PG8_SA(1, 0), cA + kstep, voffA); PG8_STAGE(PG8_SB(1, 1), cB + hstep + kstep, voffB);
        PG8_WAIT_V(6); PG8_BAR;
    } else {
        PG8_STAGE(PG8_SB(0, 0), cB, voffB); PG8_STAGE(PG8_SA(0, 0), cA, voffA); PG8_STAGE(PG8_SB(0, 1), cB + hstep, voffB); PG8_STAGE(PG8_SA(0, 1), cA + hstep, voffA);
        if (wr == 1) PG8_BAR;
        PG8_WAIT_V(4); PG8_BAR;
        PG8_STAGE(PG8_SB(1, 0), cB + kstep, voffB); PG8_STAGE(PG8_SA(1, 0), cA + kstep, voffA); PG8_STAGE(PG8_SB(1, 1), cB + hstep + kstep, voffB);
        PG8_WAIT_V(6); PG8_BAR;
    }
    for (;;) {
        const bool has_next = S.next(ui + 1, nxt);
        const char* nA = has_next ? (const char*)g.A + (size_t)nxt.pm * tstep : cA; const char* nB = has_next ? (const char*)g.Bt + (size_t)nxt.pn * tstep : cB;
        for (int t = 0; t < nt; t += 2) {
            const bool last = (t == nt - 2);
            const char* a1 = cA + (size_t)(t + 1) * kstep;
            const char* a2 = last ? nA : cA + (size_t)(t + 2) * kstep; const char* b2 = last ? nB : cB + (size_t)(t + 2) * kstep;
            const char* a3 = a2 + kstep; const char* b3 = b2 + kstep;
            if (last && has_next) S.a_ready(nxt);
            if constexpr (SP2) {
            PG8_LDB(B0, 0, 0); PG8_LDB(B1, 0, 1); PG8_SCHED; PG8_LDA(At, 0, 0); PG8_STAGE(PG8_SA(1, 1), a1 + hstep, voffA);
            PG8_WAIT_V(8); PG8_WAIT_L(0); PG8_BAR; PG8_MMA(0, 0, At, B0); PG8_MMA(0, 1, At, B1); PG8_BAR; PG8_SCHED;
            PG8_LDA(At, 0, 1); PG8_STAGE(PG8_SB(0, 0), b2, voffB); PG8_STAGE(PG8_SB(0, 1), b2 + hstep, voffB); PG8_STAGE(PG8_SA(0, 0), a2, voffA);
            PG8_WAIT_V(8); PG8_WAIT_L(0); PG8_BAR; PG8_MMA(1, 0, At, B0); PG8_MMA(1, 1, At, B1); PG8_BAR; PG8_SCHED;
            PG8_LDB(B0, 1, 0); PG8_LDB(B1, 1, 1); PG8_SCHED; PG8_LDA(At, 1, 0); PG8_STAGE(PG8_SA(0, 1), a2 + hstep, voffA);
            PG8_WAIT_V(8); PG8_WAIT_L(0); PG8_BAR; PG8_MMA(0, 0, At, B0); PG8_MMA(0, 1, At, B1); PG8_BAR; PG8_SCHED;
            PG8_LDA(At, 1, 1); PG8_STAGE(PG8_SB(1, 0), b3, voffB); PG8_STAGE(PG8_SB(1, 1), b3 + hstep, voffB); PG8_STAGE(PG8_SA(1, 0), a3, voffA);
            PG8_WAIT_V(8); PG8_WAIT_L(0); PG8_BAR; PG8_MMA(1, 0, At, B0); PG8_MMA(1, 1, At, B1); PG8_BAR; PG8_SCHED;
            } else {
            PG8_LDB(B0, 0, 0); PG8_SCHED; PG8_LDA(At, 0, 0); PG8_STAGE(PG8_SA(1, 1), a1 + hstep, voffA);
            PG8_WAIT_L(8); PG8_BAR; PG8_WAIT_L(0); PG8_MMA(0, 0, At, B0); PG8_BAR; PG8_SCHED;
            PG8_LDB(B1, 0, 1); PG8_STAGE(PG8_SB(0, 0), b2, voffB);
            PG8_BAR; PG8_WAIT_L(0); PG8_MMA(0, 1, At, B1); PG8_BAR;
            PG8_LDA(At, 0, 1); PG8_STAGE(PG8_SA(0, 0), a2, voffA);
            PG8_BAR; PG8_WAIT_L(0); PG8_MMA(1, 0, At, B0); PG8_BAR; PG8_SCHED;
            PG8_STAGE(PG8_SB(0, 1), b2 + hstep, voffB);
            PG8_WAIT_V(6); PG8_BAR; PG8_MMA(1, 1, At, B1); PG8_BAR;
            PG8_LDB(B0, 1, 0); PG8_SCHED; PG8_LDA(At, 1, 0); PG8_STAGE(PG8_SA(0, 1), a2 + hstep, voffA);
            PG8_WAIT_L(8); PG8_BAR; PG8_WAIT_L(0); PG8_MMA(0, 0, At, B0); PG8_BAR; PG8_SCHED;
            PG8_LDB(B1, 1, 1); PG8_STAGE(PG8_SB(1, 0), b3, voffB);
            PG8_BAR; PG8_WAIT_L(0); PG8_MMA(0, 1, At, B1); PG8_BAR;
            PG8_LDA(At, 1, 1); PG8_STAGE(PG8_SA(1, 0), a3, voffA);
            PG8_BAR; PG8_WAIT_L(0); PG8_MMA(1, 0, At, B0); PG8_BAR; PG8_SCHED;
            PG8_STAGE(PG8_SB(1, 1), b3 + hstep, voffB);
            PG8_WAIT_V(6); PG8_BAR; PG8_MMA(1, 1, At, B1); PG8_BAR;
            }
        }
        if constexpr (ALIGN_EPI) { if (wr == 0) PG8_BAR; }
        if constexpr (!Epi::AFTER_DRAIN) { E(acc, cur, wr, wc, fr, fq); S.done(cur); }
        if (!has_next) break;
#pragma unroll
        for (int a = 0; a < 2; ++a)
#pragma unroll
            for (int b = 0; b < 2; ++b)
#pragma unroll
                for (int m = 0; m < 4; ++m)
#pragma unroll
                    for (int n = 0; n < 2; ++n) acc[a][b][m][n] = (f32x4){0.f, 0.f, 0.f, 0.f};
        cur = nxt; cA = nA; cB = nB; ++ui;
        if constexpr (ALIGN_EPI) { if (wr == 1) PG8_BAR; }
    }
    PG8_WAIT_V(0);
    if constexpr (!ALIGN_EPI) { if (wr == 0) PG8_BAR; }
    PG8_BAR;
    if constexpr (Epi::AFTER_DRAIN) { E.fused(acc, cur, wr, wc, fr, fq, lds, wid, lane); S.done(cur); }
#undef PG8_SA
#undef PG8_SB
#undef PG8_STAGE
#undef PG8_LDA
#undef PG8_LDB
#undef PG8_MMA
#undef PG8_WAIT_V
#undef PG8_WAIT_L
#undef PG8_BAR
#undef PG8_SCHED
}
}

constexpr int NWAVES = 8;
constexpr int BATCH = 4, SEQ = 8192, D = 1024, M = BATCH * SEQ;
constexpr int BW = 512, NQKV = 4608, N1 = 5120, N2 = 3072, INW = 8192, QKVP = 1536, NGH = 24, NKEY = 129, BIASP = 132;
constexpr float RMS_EPS = 1e-6f;
constexpr float LOG2E = 1.4426950408889634f;
constexpr float C2 = 0.125f * LOG2E;
#ifndef MK_ONE_LAUNCH
#define MK_ONE_LAUNCH 1
#endif
constexpr int NPHASE = 7;

constexpr size_t MiB = 1u << 20;
constexpr size_t WS_CTL = 0, CTL_ZERO_BYTES = 1 * MiB;
constexpr size_t WS_WT1 = 2 * MiB;
constexpr size_t WS_WT2 = 12 * MiB;
constexpr size_t WS_WAT = 18 * MiB, WS_WBT = 19 * MiB, WS_WOT = 20 * MiB;
constexpr size_t WS_BIAS = 22 * MiB;
constexpr size_t WS_LSE = 23 * MiB;
constexpr size_t WS_Q = 32 * MiB, WS_K = 128 * MiB, WS_V = 224 * MiB;
constexpr size_t WS_AP = 320 * MiB;
constexpr size_t WS_MIX = 352 * MiB;
constexpr size_t WS_XN = 384 * MiB;
constexpr size_t WS_UA = 128 * MiB, WS_UB = 160 * MiB, WS_G = 192 * MiB;
constexpr size_t WS_MRG = 320 * MiB;
constexpr size_t WS_END = 448 * MiB;
constexpr int CW_BAR = 4096;

constexpr int RING_OFF = 0, RING_BYTES = 131072;
constexpr int LDSCTL_OFF = RING_BYTES, MISC_OFF = LDSCTL_OFF + 320;
constexpr int LDS_BYTES = 147456;

static_assert(WS_V - WS_K == WS_K - WS_Q, "Q|K|V equally spaced");
#define GAS __attribute__((address_space(1)))
#define LAS __attribute__((address_space(3)))
typedef unsigned short bf16;
typedef unsigned v4u __attribute__((ext_vector_type(4)));
typedef float f32x4 __attribute__((ext_vector_type(4)));
typedef short bf16x8 __attribute__((ext_vector_type(8)));
typedef GAS unsigned gu32;
typedef GAS unsigned long long gu64;
#define RLX_AGENT __ATOMIC_RELAXED, __HIP_MEMORY_SCOPE_AGENT
#define LDS_WAIT() asm volatile("s_waitcnt lgkmcnt(0)" ::: "memory")
#define VM_WAIT() asm volatile("s_waitcnt vmcnt(0)" ::: "memory")
__device__ __forceinline__ unsigned long long rt() { return __builtin_amdgcn_s_memrealtime(); }
__device__ __forceinline__ unsigned f2bf(float f) { unsigned u = __builtin_bit_cast(unsigned, f); return (u + 0x7fffu + ((u >> 16) & 1u)) >> 16; }
__device__ __forceinline__ unsigned pk2(float lo, float hi) { return f2bf(lo) | (f2bf(hi) << 16); }

#define XB_TMO      128
#define XB_XCNT(j)  (256  + 64 * (j))
#define XB_XSUB(j)  (1280 + 64 * (j))
#define XB_XGEN(j)  (2304 + 64 * (j))
#define XB_TOP      3328
#define XB_TOPGEN   3392
#define XCD_BAR_WORDS 3456
#define XB_SPIN_CAP (1u << 18)

__device__ __forceinline__ unsigned xb_ld(unsigned* p)              { return __hip_atomic_load(p, __ATOMIC_RELAXED, __HIP_MEMORY_SCOPE_AGENT); }
__device__ __forceinline__ unsigned xb_add(unsigned* p, unsigned v) { return __hip_atomic_fetch_add(p, v, __ATOMIC_RELAXED, __HIP_MEMORY_SCOPE_AGENT); }
__device__ __forceinline__ unsigned xb_xcc_id() { return (unsigned)__builtin_amdgcn_s_getreg((3 << 11) | 20) & 0xFu; }
#define XB_SPIN(cond, bar) do { unsigned _sp = 0; while (cond) { __builtin_amdgcn_s_sleep(1); \
    if ((++_sp & 255u) == 0u) { if (xb_ld(&(bar)[XB_TMO])) break; if (_sp > XB_SPIN_CAP) { atomicAdd(&(bar)[XB_TMO], 1u); break; } } } } while (0)

struct XcdBarrier {
    unsigned* bar; unsigned x;
    volatile LAS unsigned* st;
};

__device__ __forceinline__ XcdBarrier xcd_barrier_post(unsigned* bar, volatile LAS unsigned* st) {
    XcdBarrier b; b.bar = bar; b.x = xb_xcc_id(); b.st = st;
    if (threadIdx.x == 0) (void)xb_add(&bar[XB_XCNT(b.x)], 1u);
    return b;
}
__device__ __forceinline__ void xcd_barrier_complete(unsigned* bar, unsigned x, unsigned& nloc, unsigned& nx) {
    const unsigned G = gridDim.x * gridDim.y * gridDim.z;
    unsigned sum, cnt, mine, sp = 0u;
    for (;;) {
        sum = 0u; cnt = 0u; mine = 0u;
#pragma unroll
        for (unsigned j = 0; j < 16; ++j) { const unsigned c = xb_ld(&bar[XB_XCNT(j)]); sum += c; cnt += (c > 0u) ? 1u : 0u; mine = (j == x) ? c : mine; }
        if (sum == G) break;
        __builtin_amdgcn_s_sleep(1);
        if ((++sp & 255u) == 0u) { if (xb_ld(&bar[XB_TMO])) break; if (sp > XB_SPIN_CAP) { atomicAdd(&bar[XB_TMO], 1u); break; } }
    }
    nloc = mine > 0u ? mine : 1u; nx = cnt > 0u ? cnt : 1u;
}

__device__ __forceinline__ void xcd_barrier(const XcdBarrier& b) {
    asm volatile("s_waitcnt vmcnt(0)" ::: "memory");
    __syncthreads();
    if (threadIdx.x == 0) {
        unsigned* bar = b.bar;
        __builtin_amdgcn_s_waitcnt(0);
        unsigned nloc = b.st[0], nx = b.st[1];
        if (nloc == 0u) { xcd_barrier_complete(bar, b.x, nloc, nx); b.st[0] = nloc; b.st[1] = nx; }
        const unsigned old = xb_add(&bar[XB_XSUB(b.x)], 1u);
        const unsigned gen = old / nloc;
        if (old + 1u == (gen + 1u) * nloc) {
            __builtin_amdgcn_fence(__ATOMIC_RELEASE, "agent");
            asm volatile("s_waitcnt vmcnt(0)" ::: "memory");
            const unsigned og = xb_add(&bar[XB_TOP], 1u);
            const unsigned tg = og / nx;
            if (og + 1u == (tg + 1u) * nx) xb_add(&bar[XB_TOPGEN], 1u);
            else XB_SPIN(xb_ld(&bar[XB_TOPGEN]) == tg, bar);
            __builtin_amdgcn_fence(__ATOMIC_ACQUIRE, "agent");
            xb_add(&bar[XB_XGEN(b.x)], 1u);
            asm volatile("s_waitcnt vmcnt(0)" ::: "memory");
        } else {
            XB_SPIN(xb_ld(&bar[XB_XGEN(b.x)]) == gen, bar);
            __builtin_amdgcn_fence(__ATOMIC_ACQUIRE, "agent");
            asm volatile("s_waitcnt vmcnt(0)" ::: "memory");
        }
    }
    __syncthreads();
}

struct Frame {
    LAS unsigned char* lds;
    int tid, lane, wave;
    int vcu, G;
    const float *x, *norm_gain, *w_in, *b_gate, *rel_bias, *w_pool, *pool_scale, *w_proj_a, *w_proj_b, *w_out, *final_gain;
    float* out;
    bf16 *Wt1, *Wt2, *Wat, *Wbt, *Wot;
    float *BIAS, *LSE;
    bf16 *Qb, *Kb, *Vb, *AP, *MIX, *XN, *UA, *UB, *GG, *MRG;
};
__device__ __forceinline__ float wave_sum(float v) {
#pragma unroll
    for (int o = 1; o < 64; o <<= 1) v += __shfl_xor(v, o);
    return v;
}
__device__ __forceinline__ float wave_max(float v) {
#pragma unroll
    for (int o = 1; o < 64; o <<= 1) v = fmaxf(v, __shfl_xor(v, o));
    return v;
}
__device__ __forceinline__ float bf2f(unsigned short b) { return __uint_as_float(((unsigned)b) << 16); }
__device__ __forceinline__ float blo(unsigned w) { return __uint_as_float(w << 16); }
__device__ __forceinline__ float bhi(unsigned w) { return __uint_as_float(w & 0xffff0000u); }

__device__ __forceinline__ void p0_transpose_item(const float* W, int ldw, int col0, int ncols, int K, const float* gain, bf16* WT, int row_off, LAS float* scr, int item, int lane) {
    const int nblk = ncols / 32, kb = item / nblk, nb = item % nblk, k0 = 64 * kb, n0 = 32 * nb;
#pragma unroll 8
    for (int i = 0; i < 32; ++i) { const int kk = 2 * i + (lane >> 5); float v = W[(size_t)(k0 + kk) * ldw + col0 + n0 + (lane & 31)]; if (gain) v *= gain[k0 + kk]; scr[kk * 33 + (lane & 31)] = v; }
    LDS_WAIT(); asm volatile("" ::: "memory");
    const int c = lane & 7;
#pragma unroll
    for (int j = 0; j < 4; ++j) { const int n = (lane >> 3) + 8 * j; const LAS float* s = scr + (8 * c) * 33 + n;
        v4u o; o.x = pk2(s[0 * 33], s[1 * 33]); o.y = pk2(s[2 * 33], s[3 * 33]); o.z = pk2(s[4 * 33], s[5 * 33]); o.w = pk2(s[6 * 33], s[7 * 33]);
        *(GAS v4u*)(WT + (size_t)(row_off + n0 + n) * K + k0 + 8 * c) = o; }
    LDS_WAIT(); asm volatile("" ::: "memory");
}
__device__ __forceinline__ void rms_row_to_bf16(const float* xrow, bf16* orow, int lane) {
    const GAS f32x4* xr = (const GAS f32x4*)xrow + lane;
    f32x4 v[4]; float s = 0.f;
#pragma unroll
    for (int j = 0; j < 4; ++j) { v[j] = xr[64 * j]; s += (v[j].x * v[j].x + v[j].y * v[j].y) + (v[j].z * v[j].z + v[j].w * v[j].w); }
    const float r = 1.0f / sqrtf(wave_sum(s) * (1.f / D) + RMS_EPS);
    GAS unsigned long long* o8 = (GAS unsigned long long*)orow + lane;
#pragma unroll
    for (int j = 0; j < 4; ++j) o8[64 * j] = (unsigned long long)pk2(v[j].x * r, v[j].y * r) | ((unsigned long long)pk2(v[j].z * r, v[j].w * r) << 32);
}
__device__ __forceinline__ int t5_bucket(int rel) {
    const int nb = 16, max_exact = 8;
    const int ret = (rel > 0) ? nb : 0;
    const int n = rel < 0 ? -rel : rel;
    const float nf = (float)(n > 1 ? n : 1);
    int large = max_exact + (int)(logf(nf / (float)max_exact) / logf(1024.0f / (float)max_exact) * (float)(nb - max_exact));
    large = large < nb - 1 ? large : nb - 1;
    return ret + (n < max_exact ? n : large);
}
__device__ __forceinline__ void p0_prologue(Frame& F) {
    {
        LAS float* tile = (LAS float*)(F.lds + RING_OFF);
        for (int task = F.vcu; task < 16 * 4 * 4; task += F.G) {
            const int kb = task >> 4, gp = (task >> 2) & 3, dq = task & 3;
            __syncthreads();
#pragma unroll
            for (int i = 0; i < 16; ++i) { const int e = F.tid + 512 * i, kk = e >> 7, c = e & 127; tile[kk * 129 + c] = F.w_in[(size_t)(kb * 64 + kk) * INW + gp * 128 + c]; }
            __syncthreads();
            const int k = kb * 64 + F.lane; float a[4] = {0.f, 0.f, 0.f, 0.f}; const int d0 = dq * 32 + F.wave * 4;
            const float* wp = F.w_pool + (size_t)gp * 16384 + d0;
            for (int c = 0; c < 128; ++c) { const float t = tile[F.lane * 129 + c];
#pragma unroll
                for (int i = 0; i < 4; ++i) a[i] += t * wp[c * 128 + i]; }
            const float gk = F.norm_gain[k];
#pragma unroll
            for (int i = 0; i < 4; ++i) { const int cp = gp * 128 + d0 + i; F.Wt1[(size_t)(NQKV + cp) * D + k] = (bf16)f2bf(a[i] * gk * F.pool_scale[cp]); }
        }
        __syncthreads();
    }
    LAS float* scr = (LAS float*)(F.lds + RING_OFF + F.wave * 16384);
    const int gw = F.vcu * NWAVES + F.wave, NGW = F.G * NWAVES;
    constexpr int I_QKV = (D / 64) * (NQKV / 32), I_AG = (D / 64) * (BW / 32), I_GL = (D / 64) * (2 * D / 32), I_PA = (BW / 64) * (D / 32), I_WO = (D / 64) * (D / 32);
    constexpr int NITEMS = I_QKV + 2 * I_AG + I_GL + 2 * I_PA + I_WO;
    for (int it = gw; it < NITEMS; it += NGW) {
        int r = it;
        if (r < I_QKV) { p0_transpose_item(F.w_in, INW, 1024, NQKV, D, F.norm_gain, F.Wt1, 0, scr, r, F.lane); continue; } r -= I_QKV;
        if (r < I_AG)  { p0_transpose_item(F.w_in, INW, 512, BW, D, F.norm_gain, F.Wt2, 0, scr, r, F.lane); continue; } r -= I_AG;
        if (r < I_AG)  { p0_transpose_item(F.w_in, INW, 5632, BW, D, F.norm_gain, F.Wt2, 512, scr, r, F.lane); continue; } r -= I_AG;
        if (r < I_GL)  { p0_transpose_item(F.w_in, INW, 6144, 2 * D, D, F.norm_gain, F.Wt2, 1024, scr, r, F.lane); continue; } r -= I_GL;
        if (r < I_PA)  { p0_transpose_item(F.w_proj_a, D, 0, D, BW, nullptr, F.Wat, 0, scr, r, F.lane); continue; } r -= I_PA;
        if (r < I_PA)  { p0_transpose_item(F.w_proj_b, D, 0, D, BW, nullptr, F.Wbt, 0, scr, r, F.lane); continue; } r -= I_PA;
        p0_transpose_item(F.w_out, D, 0, D, D, nullptr, F.Wot, 0, scr, r, F.lane);
    }
    for (int m = gw; m < M; m += NGW) rms_row_to_bf16(F.x + (size_t)m * D, F.XN + (size_t)m * D, F.lane);
    for (int idx = (int)blockIdx.x * 512 + F.tid; idx < NGH * BIASP; idx += F.G * 512) {
        const int gh = idx / BIASP, j = idx % BIASP, g = gh >> 3; const int dil = (g == 0) ? 1 : ((g == 1) ? 4 : 16);
        float v = 0.f; if (j < NKEY) v = F.rel_bias[t5_bucket((j - 64) * dil) * NGH + gh] * LOG2E;
        F.BIAS[idx] = v;
    }
}

__device__ __forceinline__ void p2_attention_simple(Frame& F) {
    LAS float* pbuf = (LAS float*)(F.lds + RING_OFF + F.wave * 1024);
    const int gw = F.vcu * NWAVES + F.wave, NGW = F.G * NWAVES, lane = F.lane;
    for (int task = gw; task < M * NGH; task += NGW) {
        const int t = task / NGH, gh = task - t * NGH, g = gh >> 3, h = gh & 7;
        const int pos = t & (SEQ - 1), dil = (g == 0) ? 1 : ((g == 1) ? 4 : 16);
        const size_t hoff = (size_t)g * 512 + h * 64;
        bf16* qrow = F.Qb + (size_t)t * QKVP + hoff;
        float q[64];
#pragma unroll
        for (int i = 0; i < 8; ++i) { const v4u w = *(const GAS v4u*)(qrow + 8 * i);
            q[8 * i + 0] = blo(w.x); q[8 * i + 1] = bhi(w.x); q[8 * i + 2] = blo(w.y); q[8 * i + 3] = bhi(w.y); q[8 * i + 4] = blo(w.z); q[8 * i + 5] = bhi(w.z); q[8 * i + 6] = blo(w.w); q[8 * i + 7] = bhi(w.w); }
        float s[3];
#pragma unroll
        for (int jj = 0; jj < 3; ++jj) {
            const int j = lane + 64 * jj, kpos = pos + (j - 64) * dil; const bool valid = (j < NKEY) && (kpos >= 0) && (kpos < SEQ);
            float dot = -INFINITY;
            if (valid) { const bf16* krow = F.Kb + (size_t)(t - pos + kpos) * QKVP + hoff; dot = 0.f;
#pragma unroll
                for (int i = 0; i < 8; ++i) { const v4u w = *(const GAS v4u*)(krow + 8 * i);
                    dot += q[8 * i + 0] * blo(w.x) + q[8 * i + 1] * bhi(w.x) + q[8 * i + 2] * blo(w.y) + q[8 * i + 3] * bhi(w.y) + q[8 * i + 4] * blo(w.z) + q[8 * i + 5] * bhi(w.z) + q[8 * i + 6] * blo(w.w) + q[8 * i + 7] * bhi(w.w); }
                dot += F.BIAS[gh * BIASP + j]; }
            s[jj] = dot;
        }
        const float mx = wave_max(fmaxf(fmaxf(s[0], s[1]), s[2]));
        float lsum = 0.f;
#pragma unroll
        for (int jj = 0; jj < 3; ++jj) { const float p = __builtin_amdgcn_exp2f(s[jj] - mx); pbuf[lane + 64 * jj] = p; lsum += p; }
        lsum = wave_sum(lsum);
        LDS_WAIT(); asm volatile("" ::: "memory");
        float o = 0.f;
        for (int j = 0; j < NKEY; ++j) { const int kpos = pos + (j - 64) * dil;
            if (kpos >= 0 && kpos < SEQ) o += pbuf[j] * bf2f(F.Vb[(size_t)(t - pos + kpos) * QKVP + hoff + lane]); }
        LDS_WAIT(); asm volatile("" ::: "memory");
        qrow[lane] = (bf16)f2bf(o / lsum);
        if (lane == 0) F.LSE[(size_t)t * NGH + gh] = mx + log2f(lsum);
    }
}
__device__ __forceinline__ void p2_pool(Frame& F) {
    const int gw = F.vcu * NWAVES + F.wave, NGW = F.G * NWAVES, lane = F.lane;
    const int half = 1 << (lane >> 4);
    for (int t = gw; t < M; t += NGW) {
        const int pos = t & (SEQ - 1);
        const bf16* base = F.AP + (size_t)(t - pos) * BW + lane * 8;
        float acc[8] = {0.f, 0.f, 0.f, 0.f, 0.f, 0.f, 0.f, 0.f}; int cnt = 0;
#pragma unroll
        for (int j = 0; j < 16; ++j) { const int row = pos - half + j;
            if (j < 2 * half && row >= 0 && row < SEQ) { const v4u w = *(const GAS v4u*)(base + (size_t)row * BW); ++cnt;
                acc[0] += blo(w.x); acc[1] += bhi(w.x); acc[2] += blo(w.y); acc[3] += bhi(w.y); acc[4] += blo(w.z); acc[5] += bhi(w.z); acc[6] += blo(w.w); acc[7] += bhi(w.w); } }
        const v4u cw = *(const GAS v4u*)(base + (size_t)pos * BW); const float fc = (float)cnt;
        v4u o; o.x = pk2(acc[0] / fc - blo(cw.x), acc[1] / fc - bhi(cw.x)); o.y = pk2(acc[2] / fc - blo(cw.y), acc[3] / fc - bhi(cw.y));
        o.z = pk2(acc[4] / fc - blo(cw.z), acc[5] / fc - bhi(cw.z)); o.w = pk2(acc[6] / fc - blo(cw.w), acc[7] / fc - bhi(cw.w));
        *(GAS v4u*)(F.MIX + (size_t)t * BW + lane * 8) = o;
    }
}
__device__ __forceinline__ void p6_final_norm(Frame& F) {
    const int gw = F.vcu * NWAVES + F.wave, NGW = F.G * NWAVES, lane = F.lane;
    f32x4 gn[4];
#pragma unroll
    for (int j = 0; j < 4; ++j) gn[j] = ((const GAS f32x4*)F.final_gain)[lane + 64 * j];
    for (int m = gw; m < M; m += NGW) {
        GAS f32x4* yr = (GAS f32x4*)(F.out + (size_t)m * D) + lane;
        f32x4 v[4]; float s = 0.f;
#pragma unroll
        for (int j = 0; j < 4; ++j) { v[j] = yr[64 * j]; s += (v[j].x * v[j].x + v[j].y * v[j].y) + (v[j].z * v[j].z + v[j].w * v[j].w); }
        const float r = 1.0f / sqrtf(wave_sum(s) * (1.f / D) + RMS_EPS);
#pragma unroll
        for (int j = 0; j < 4; ++j) yr[64 * j] = v[j] * r * gn[j];
    }
}

struct Args { const float* in[11]; float* out; unsigned char* ws; int ph_lo, ph_hi; };
__global__ void __launch_bounds__(NWAVES * 64, 2) skel_fwd(Args args) {
    extern __shared__ __attribute__((aligned(16))) unsigned char lds[];
    Frame F;
    F.lds = (LAS unsigned char*)lds;
    F.tid = threadIdx.x; F.lane = F.tid & 63; F.wave = __builtin_amdgcn_readfirstlane(F.tid >> 6);
    F.G = gridDim.x; { const int bx = blockIdx.x; F.vcu = (F.G % 8 == 0) ? (bx % 8) * (F.G / 8) + bx / 8 : bx; }
    unsigned char* ws = args.ws;
    F.x = args.in[0]; F.norm_gain = args.in[1]; F.w_in = args.in[2]; F.b_gate = args.in[3]; F.rel_bias = args.in[4]; F.w_pool = args.in[5]; F.pool_scale = args.in[6];
    F.w_proj_a = args.in[7]; F.w_proj_b = args.in[8]; F.w_out = args.in[9]; F.final_gain = args.in[10]; F.out = args.out;
    F.Wt1 = (bf16*)(ws + WS_WT1); F.Wt2 = (bf16*)(ws + WS_WT2); F.Wat = (bf16*)(ws + WS_WAT); F.Wbt = (bf16*)(ws + WS_WBT); F.Wot = (bf16*)(ws + WS_WOT);
    F.BIAS = (float*)(ws + WS_BIAS); F.LSE = (float*)(ws + WS_LSE);
    F.Qb = (bf16*)(ws + WS_Q); F.Kb = (bf16*)(ws + WS_K); F.Vb = (bf16*)(ws + WS_V); F.AP = (bf16*)(ws + WS_AP); F.MIX = (bf16*)(ws + WS_MIX); F.XN = (bf16*)(ws + WS_XN);
    F.UA = (bf16*)(ws + WS_UA); F.UB = (bf16*)(ws + WS_UB); F.GG = (bf16*)(ws + WS_G); F.MRG = (bf16*)(ws + WS_MRG);
    for (int u = F.tid; u < (LDS_BYTES - LDSCTL_OFF) / 4; u += NWAVES * 64) ((LAS unsigned*)(F.lds + LDSCTL_OFF))[u] = 0u;
    __syncthreads();
    const int lo = args.ph_lo, hi = args.ph_hi;
    XcdBarrier bar; bar.bar = (unsigned*)(ws + WS_CTL) + CW_BAR; bar.x = 0; bar.st = nullptr;
    if (hi - lo > 1) bar = xcd_barrier_post((unsigned*)(ws + WS_CTL) + CW_BAR, (volatile LAS unsigned*)(F.lds + MISC_OFF) + 8);
#define IN(k) (lo <= (k) && (k) < hi)
#define SEAM(k) do { if (IN(k) && IN((k) + 1)) xcd_barrier(bar); } while (0)

    if (IN(0)) { p0_prologue(F); SEAM(0); }
    if (IN(1)) {
        pg8::Gemm g{F.XN, F.Wt1, M, N1, D}; pg8::StaticOrder S; S.init(M, N1, F.G, (int)blockIdx.x);
        pg8::EpiP1 E{F.Qb, (size_t)(WS_K - WS_Q) / 2, F.AP, C2};
        pg8::gemm_phase<pg8::EpiP1, pg8::StaticOrder, true, true>(F.lds + RING_OFF, g, S, E);
        SEAM(1);
    }
    if (IN(2)) { p2_attention_simple(F); p2_pool(F); SEAM(2); }
    if (IN(3)) {
        pg8::Gemm g{F.XN, F.Wt2, M, N2, D}; pg8::StaticOrder S; S.init(M, N2, F.G, (int)blockIdx.x);
        pg8::EpiP3 E{F.MIX, F.Qb, F.LSE, F.b_gate, F.UA, F.UB, F.GG};
        pg8::gemm_phase<pg8::EpiP3, pg8::StaticOrder, true, true>(F.lds + RING_OFF, g, S, E);
        SEAM(3);
    }
    if (IN(4)) {
        { pg8::Gemm g{F.UA, F.Wat, M, D, BW}; pg8::StaticOrder S; S.init(M, D, F.G, (int)blockIdx.x);
          pg8::EpiP4<false> E{F.GG, F.MRG};
          pg8::gemm_phase<pg8::EpiP4<false>, pg8::StaticOrder, true, true>(F.lds + RING_OFF, g, S, E); }
        { pg8::Gemm g{F.UB, F.Wbt, M, D, BW}; pg8::StaticOrder S; S.init(M, D, F.G, (int)blockIdx.x);
          pg8::EpiP4<true> E{F.GG, F.MRG};
          pg8::gemm_phase<pg8::EpiP4<true>, pg8::StaticOrder, true, true>(F.lds + RING_OFF, g, S, E); }
        SEAM(4);
    }
    if (IN(5)) {
        pg8::Gemm g{F.MRG, F.Wot, M, D, D}; pg8::StaticOrder S; S.init(M, D, F.G, (int)blockIdx.x);
        pg8::EpiP5 E{F.x, F.out};
        pg8::gemm_phase<pg8::EpiP5, pg8::StaticOrder, true, true>(F.lds + RING_OFF, g, S, E);
        SEAM(5);
    }
    if (IN(6)) { p6_final_norm(F); }
#undef IN
#undef SEAM
}

extern "C" void kernel_launch(void* const* d_in, const int* in_sizes, int n_in, void* d_out, int out_size, void* d_ws, size_t ws_size, hipStream_t stream) {
    static int grid = 0;
    if (grid == 0) {
        if (n_in != 11 || in_sizes[0] != M * D || out_size != M * D || ws_size < WS_END) { fprintf(stderr, "kernel_launch: unexpected shapes (n_in %d, in0 %d, out %d, ws %zu); nothing launched\n", n_in, n_in > 0 ? in_sizes[0] : -1, out_size, ws_size); grid = -1; return; }
        int dev = 0, cus = 0, per_cu = 0;
        if (hipGetDevice(&dev) != hipSuccess || hipDeviceGetAttribute(&cus, hipDeviceAttributeMultiprocessorCount, dev) != hipSuccess) { grid = -1; return; }
        if (hipFuncSetAttribute((const void*)skel_fwd, hipFuncAttributeMaxDynamicSharedMemorySize, LDS_BYTES) != hipSuccess) { fprintf(stderr, "kernel_launch: hipFuncSetAttribute failed\n"); grid = -1; return; }
        if (hipOccupancyMaxActiveBlocksPerMultiprocessor(&per_cu, (const void*)skel_fwd, NWAVES * 64, LDS_BYTES) != hipSuccess || per_cu < 1) { fprintf(stderr, "kernel_launch: occupancy query reports %d\n", per_cu); }
        (void)hipGetLastError();
        grid = cus;
    }
    if (grid < 0) return;
    if (hipMemsetAsync((char*)d_ws + WS_CTL, 0, CTL_ZERO_BYTES, stream) != hipSuccess) return;
    Args a{};
    for (int i = 0; i < 11; ++i) a.in[i] = (const float*)d_in[i];
    a.out = (float*)d_out; a.ws = (unsigned char*)d_ws;
#if MK_ONE_LAUNCH
    a.ph_lo = 0; a.ph_hi = NPHASE;
    hipLaunchKernelGGL(skel_fwd, dim3(grid), dim3(NWAVES * 64), LDS_BYTES, stream, a);
#else
    for (int p = 0; p < NPHASE; ++p) { a.ph_lo = p; a.ph_hi = p + 1; hipLaunchKernelGGL(skel_fwd, dim3(grid), dim3(NWAVES * 64), LDS_BYTES, stream, a); }
#endif
}
```

```cpp
#include <hip/hip_runtime.h>
#include <cstdio>
#include <cstdint>
namespace pg8 {
#define PG8_LAS __attribute__((address_space(3)))
typedef unsigned short bf16_t;
typedef short bf16x8 __attribute__((ext_vector_type(8)));
typedef float f32x4 __attribute__((ext_vector_type(4)));
typedef unsigned u32x4 __attribute__((ext_vector_type(4)));
constexpr int BM = 256, BK = 64, HALF = 128, HTB = HALF * BK * 2  , STAGE_BYTES = 8 * HTB, NXCD = 8, WGM = 8;

__host__ __device__ __forceinline__ int lds_byte(int r, int c) { const int st = (r >> 4) * 2 + (c >> 5), rr = r & 15, cc = c & 31, ob = rr * 64 + cc * 2; return st * 1024 + (ob ^ (((ob >> 9) & 1) << 5)); }
__host__ __device__ __forceinline__ void stage_rc(int b, int& R, int& C) { const int st = b / 1024, sb = b % 1024, swz = sb ^ (((sb >> 9) & 1) << 5); R = (st >> 1) * 16 + swz / 64; C = (st & 1) * 32 + (swz % 64) / 2; }
__host__ __device__ __forceinline__ int perm32(int rho) { const int n = rho >> 4, i = rho & 15; return 8 * (i >> 2) + 4 * n + (i & 3); }

struct Unit { int pm, pn; };
struct Gemm { const bf16_t* A; const bf16_t* Bt; int M, N, K; };

struct StaticOrder {
    int nM, nN, nwg, G, c;
    __host__ __device__ void init(int M, int N, int G_, int c_) { nM = M / BM; nN = N / BM; nwg = nM * nN; G = G_; c = c_; }
    __host__ __device__ bool next(int i, Unit& u) const {
        const long L = (long)i * G + c; if (L >= nwg) return false;
        int wgid = (int)L; { const int q = nwg / NXCD, r = nwg % NXCD, xcd = wgid % NXCD, off = wgid / NXCD; wgid = (xcd < r ? xcd * (q + 1) : r * (q + 1) + (xcd - r) * q) + off; }
        const int nig = WGM * nN, gid = wgid / nig, fm = gid * WGM, gsz = (nM - fm) < WGM ? (nM - fm) : WGM;
        u.pm = fm + ((wgid % nig) % gsz); u.pn = (wgid % nig) / gsz; return true;
    }
    __device__ __forceinline__ void a_ready(const Unit&) const {}
    __device__ __forceinline__ void done(const Unit&) const {}
};
typedef float f32x2_t __attribute__((ext_vector_type(2))); typedef __bf16 bf16x2_t __attribute__((ext_vector_type(2)));
__device__ __forceinline__ unsigned cvt_pk_bf16(float lo, float hi) { f32x2_t v = {lo, hi}; bf16x2_t b = __builtin_convertvector(v, bf16x2_t); return __builtin_bit_cast(unsigned, b); }
__device__ __forceinline__ float bflo(unsigned w) { return __uint_as_float(w << 16); }
__device__ __forceinline__ float bfhi(unsigned w) { return __uint_as_float(w & 0xffff0000u); }
__device__ __forceinline__ float sigm(float x) { return __builtin_amdgcn_rcpf(1.0f + __builtin_amdgcn_exp2f(-1.4426950408889634f * x)); }
__device__ __forceinline__ u32x4 pack8(const f32x4 a, const f32x4 b) { u32x4 w; w.x = cvt_pk_bf16(a[0], a[1]); w.y = cvt_pk_bf16(a[2], a[3]); w.z = cvt_pk_bf16(b[0], b[1]); w.w = cvt_pk_bf16(b[2], b[3]); return w; }
__device__ __forceinline__ void unpack8(const u32x4 w, f32x4& a, f32x4& b) { a[0] = bflo(w.x); a[1] = bfhi(w.x); a[2] = bflo(w.y); a[3] = bfhi(w.y); b[0] = bflo(w.z); b[1] = bfhi(w.z); b[2] = bflo(w.w); b[3] = bfhi(w.w); }

struct EpiP1 {
    static constexpr bool PERM = true, AFTER_DRAIN = false;
    bf16_t* QKV; size_t tstride; bf16_t* AP; float qscale;
    __device__ __forceinline__ void operator()(const f32x4 (&acc)[2][2][4][2], const Unit& u, int wr, int wc, int fr, int fq) const {
        const int row0 = u.pm * BM + wr * 64 + fr;
        const bool isq = u.pn < 18; const int t = u.pn / 6;
        bf16_t* base = isq ? QKV + (size_t)t * tstride : AP;
        const int ldc = isq ? 1536 : 512, colt = isq ? (u.pn - 6 * t) * BM : (u.pn - 18) * BM;
        const float sc = (u.pn < 6) ? qscale : 1.f;
        const int col0 = colt + wc * 32 + 8 * fq;
#pragma unroll
        for (int ai = 0; ai < 2; ++ai)
#pragma unroll
            for (int m = 0; m < 4; ++m) { bf16_t* rowp = base + (size_t)(row0 + ai * HALF + m * 16) * ldc + col0;
#pragma unroll
                for (int bj = 0; bj < 2; ++bj) *(u32x4*)(rowp + bj * HALF) = pack8(acc[ai][bj][m][0] * sc, acc[ai][bj][m][1] * sc); }
    }
};
struct EpiP3 {
    static constexpr bool PERM = true, AFTER_DRAIN = false;
    const bf16_t* MIX; const bf16_t* ON; const float* LSE; const float* bgate; bf16_t* UA; bf16_t* UB; bf16_t* G;
    __device__ __forceinline__ void operator()(const f32x4 (&acc)[2][2][4][2], const Unit& u, int wr, int wc, int fr, int fq) const {
        const int row0 = u.pm * BM + wr * 64 + fr;
        if (u.pn < 2) {
            const int col0 = u.pn * BM + wc * 32 + 8 * fq;
#pragma unroll
            for (int ai = 0; ai < 2; ++ai)
#pragma unroll
                for (int m = 0; m < 4; ++m) { const size_t r = (size_t)(row0 + ai * HALF + m * 16);
#pragma unroll
                    for (int bj = 0; bj < 2; ++bj) { const int c = col0 + bj * HALF; f32x4 m0, m1; unpack8(*(const u32x4*)(MIX + r * 512 + c), m0, m1);
                        f32x4 v0 = acc[ai][bj][m][0], v1 = acc[ai][bj][m][1];
#pragma unroll
                        for (int i = 0; i < 4; ++i) { v0[i] = v0[i] * sigm(v0[i]) * m0[i]; v1[i] = v1[i] * sigm(v1[i]) * m1[i]; }
                        *(u32x4*)(UA + r * 512 + c) = pack8(v0, v1); } }
        } else if (u.pn < 4) {
            const int col0 = (u.pn - 2) * BM + wc * 32 + 8 * fq;
#pragma unroll
            for (int ai = 0; ai < 2; ++ai)
#pragma unroll
                for (int m = 0; m < 4; ++m) { const size_t r = (size_t)(row0 + ai * HALF + m * 16);
#pragma unroll
                    for (int bj = 0; bj < 2; ++bj) { const int c = col0 + bj * HALF, h = c >> 6;
                        const float l0 = LSE[r * 24 + h], l1 = LSE[r * 24 + 8 + h], l2 = LSE[r * 24 + 16 + h];
                        const float mx = fmaxf(fmaxf(l0, l1), l2);
                        float e0 = __builtin_amdgcn_exp2f(l0 - mx), e1 = __builtin_amdgcn_exp2f(l1 - mx), e2 = __builtin_amdgcn_exp2f(l2 - mx);
                        const float inv = __builtin_amdgcn_rcpf(e0 + e1 + e2); e0 *= inv; e1 *= inv; e2 *= inv;
                        f32x4 a0, a1, b0, b1, c0, c1;
                        unpack8(*(const u32x4*)(ON + r * 1536 + c), a0, a1); unpack8(*(const u32x4*)(ON + r * 1536 + 512 + c), b0, b1); unpack8(*(const u32x4*)(ON + r * 1536 + 1024 + c), c0, c1);
                        f32x4 v0 = acc[ai][bj][m][0], v1 = acc[ai][bj][m][1];
#pragma unroll
                        for (int i = 0; i < 4; ++i) { v0[i] = v0[i] * sigm(v0[i]) * (e0 * a0[i] + e1 * b0[i] + e2 * c0[i]); v1[i] = v1[i] * sigm(v1[i]) * (e0 * a1[i] + e1 * b1[i] + e2 * c1[i]); }
                        *(u32x4*)(UB + r * 512 + c) = pack8(v0, v1); } }
        } else {
            const int col0 = (u.pn - 4) * BM + wc * 32 + 8 * fq;
            f32x4 bv[2][2];
#pragma unroll
            for (int bj = 0; bj < 2; ++bj)
#pragma unroll
                for (int n = 0; n < 2; ++n) bv[bj][n] = *(const f32x4*)(bgate + col0 + bj * HALF + 4 * n);
#pragma unroll
            for (int ai = 0; ai < 2; ++ai)
#pragma unroll
                for (int m = 0; m < 4; ++m) { const size_t r = (size_t)(row0 + ai * HALF + m * 16);
#pragma unroll
                    for (int bj = 0; bj < 2; ++bj) { f32x4 v0 = acc[ai][bj][m][0] + bv[bj][0], v1 = acc[ai][bj][m][1] + bv[bj][1];
#pragma unroll
                        for (int i = 0; i < 4; ++i) { v0[i] = sigm(v0[i]); v1[i] = sigm(v1[i]); }
                        *(u32x4*)(G + r * 2048 + col0 + bj * HALF) = pack8(v0, v1); } }
        }
    }
};
template <bool SECOND> struct EpiP4 {
    static constexpr bool PERM = true, AFTER_DRAIN = false;
    const bf16_t* G; bf16_t* Y;
    __device__ __forceinline__ void operator()(const f32x4 (&acc)[2][2][4][2], const Unit& u, int wr, int wc, int fr, int fq) const {
        const int row0 = u.pm * BM + wr * 64 + fr, col0 = u.pn * BM + wc * 32 + 8 * fq;
#pragma unroll
        for (int ai = 0; ai < 2; ++ai)
#pragma unroll
            for (int m = 0; m < 4; ++m) { const size_t r = (size_t)(row0 + ai * HALF + m * 16);
#pragma unroll
                for (int bj = 0; bj < 2; ++bj) { const int c = col0 + bj * HALF; f32x4 g0, g1; unpack8(*(const u32x4*)(G + r * 2048 + (SECOND ? 1024 : 0) + c), g0, g1);
                    f32x4 v0 = acc[ai][bj][m][0] * g0, v1 = acc[ai][bj][m][1] * g1;
                    if (SECOND) { f32x4 y0, y1; unpack8(*(const u32x4*)(Y + r * 1024 + c), y0, y1); v0 += y0; v1 += y1; }
                    *(u32x4*)(Y + r * 1024 + c) = pack8(v0, v1); } }
    }
};
struct EpiP5 {
    static constexpr bool PERM = false, AFTER_DRAIN = false;
    const float* X; float* O;
    __device__ __forceinline__ void operator()(const f32x4 (&acc)[2][2][4][2], const Unit& u, int wr, int wc, int fr, int fq) const {
        const int row0 = u.pm * BM + wr * 64 + fr, col0 = u.pn * BM + wc * 32 + 4 * fq;
#pragma unroll
        for (int ai = 0; ai < 2; ++ai)
#pragma unroll
            for (int m = 0; m < 4; ++m) { const size_t r = (size_t)(row0 + ai * HALF + m * 16);
#pragma unroll
                for (int bj = 0; bj < 2; ++bj)
#pragma unroll
                    for (int n = 0; n < 2; ++n) { const size_t off = r * 1024 + col0 + bj * HALF + n * 16; *(f32x4*)(O + off) = *(const f32x4*)(X + off) + acc[ai][bj][m][n]; } }
    }
};

template <class Epi, class Sched, bool ALIGN_EPI = false, bool SP2 = false>
__device__ __forceinline__ void gemm_phase(PG8_LAS unsigned char* lds, const Gemm g, const Sched& S, const Epi& E) {
    const int tid = threadIdx.x, wid = __builtin_amdgcn_readfirstlane(tid >> 6), lane = tid & 63, wr = wid >> 2, wc = wid & 3, fr = lane & 15, fq = lane >> 4;
    const int K = g.K, nt = K / BK;
    unsigned voffA[2], voffB[2];
#pragma unroll
    for (int i = 0; i < 2; ++i) { int R, C; stage_rc(tid * 16 + i * 8192, R, C); const int Rb = Epi::PERM ? ((R & ~31) + perm32(R & 31)) : R;
        voffA[i] = (unsigned)(R * K + C) * 2u; voffB[i] = (unsigned)(Rb * K + C) * 2u; }
    const size_t kstep = (size_t)(BK * 2);
    const size_t hstep = (size_t)HALF * K * 2;
    const size_t tstep = 2 * hstep;
    const unsigned ldsw = (unsigned)wid * 1024u;
    const int aoff = lds_byte(wr * 64 + fr, fq * 8), boff = lds_byte(wc * 32 + fr, fq * 8);
#define PG8_SA(b, h) (((b) * 2 + (h)) * HTB)
#define PG8_SB(b, h) ((4 + (b) * 2 + (h)) * HTB)
#define PG8_STAGE(bufoff, gbase, voff) do { _Pragma("unroll") for (int _i = 0; _i < 2; ++_i) \
        __builtin_amdgcn_global_load_lds((const unsigned*)((const char*)(gbase) + (voff)[_i]), (PG8_LAS unsigned*)(lds + (bufoff) + ldsw + _i * 8192), 16, 0, 0); } while (0)
#define PG8_LDA(dst, b, h) do { _Pragma("unroll") for (int m = 0; m < 4; ++m) _Pragma("unroll") for (int k = 0; k < 2; ++k) dst[m][k] = *(const PG8_LAS bf16x8*)(lds + PG8_SA(b, h) + aoff + m * 2048 + k * 1024); } while (0)
#define PG8_LDB(dst, b, h) do { _Pragma("unroll") for (int n = 0; n < 2; ++n) _Pragma("unroll") for (int k = 0; k < 2; ++k) dst[n][k] = *(const PG8_LAS bf16x8*)(lds + PG8_SB(b, h) + boff + n * 2048 + k * 1024); } while (0)
#define PG8_MMA(ai, bj, At, Bt) do { __builtin_amdgcn_s_setprio(1); _Pragma("unroll") for (int m = 0; m < 4; ++m) _Pragma("unroll") for (int n = 0; n < 2; ++n) _Pragma("unroll") for (int k = 0; k < 2; ++k) \
        acc[ai][bj][m][n] = __builtin_amdgcn_mfma_f32_16x16x32_bf16(Bt[n][k], At[m][k], acc[ai][bj][m][n], 0, 0, 0); __builtin_amdgcn_s_setprio(0); } while (0)
#define PG8_WAIT_V(n) asm volatile("s_waitcnt vmcnt(" #n ")" ::: "memory")
#define PG8_WAIT_L(n) asm volatile("s_waitcnt lgkmcnt(" #n ")" ::: "memory")
#define PG8_BAR __builtin_amdgcn_s_barrier()
#define PG8_SCHED __builtin_amdgcn_sched_barrier(0)
    Unit cur, nxt; int ui = 0;
    if (!S.next(0, cur)) return;
    f32x4 acc[2][2][4][2];
#pragma unroll
    for (int a = 0; a < 2; ++a)
#pragma unroll
        for (int b = 0; b < 2; ++b)
#pragma unroll
            for (int m = 0; m < 4; ++m)
#pragma unroll
                for (int n = 0; n < 2; ++n) acc[a][b][m][n] = (f32x4){0.f, 0.f, 0.f, 0.f};
    bf16x8 At[4][2], B0[2][2], B1[2][2];
    const char* cA = (const char*)g.A + (size_t)cur.pm * tstep; const char* cB = (const char*)g.Bt + (size_t)cur.pn * tstep;
    S.a_ready(cur);
    if constexpr (SP2) {
        PG8_STAGE(PG8_SB(0, 0), cB, voffB); PG8_STAGE(PG8_SB(0, 1), cB + hstep, voffB); PG8_STAGE(PG8_SA(0, 0), cA, voffA); PG8_STAGE(PG8_SA(0, 1), cA + hstep, voffA);
        if (wr == 1) PG8_BAR;
        PG8_WAIT_V(2); PG8_BAR;
        PG8_STAGE(PG8_SB(1, 0), cB + kstep, voffB); PG8_STAGE(PG8_SA(1, 0), cA + kstep, voffA); PG8_STAGE(PG8_SB(1, 1), cB + hstep + kstep, voffB);
        PG8_WAIT_V(6); PG8_BAR;
    } else {
        PG8_STAGE(PG8_SB(0, 0), cB, voffB); PG8_STAGE(PG8_SA(0, 0), cA, voffA); PG8_STAGE(PG8_SB(0, 1), cB + hstep, voffB); PG8_STAGE(PG8_SA(0, 1), cA + hstep, voffA);
        if (wr == 1) PG8_BAR;
        PG8_WAIT_V(4); PG8_BAR;
        PG8_STAGE(PG8_SB(1, 0), cB + kstep, voffB); PG8_STAGE(PG8_SA(1, 0), cA + kstep, voffA); PG8_STAGE(PG8_SB(1, 1), cB + hstep + kstep, voffB);
        PG8_WAIT_V(6); PG8_BAR;
    }
    for (;;) {
        const bool has_next = S.next(ui + 1, nxt);
        const char* nA = has_next ? (const char*)g.A + (size_t)nxt.pm * tstep : cA; const char* nB = has_next ? (const char*)g.Bt + (size_t)nxt.pn * tstep : cB;
        for (int t = 0; t < nt; t += 2) {
            const bool last = (t == nt - 2);
            const char* a1 = cA + (size_t)(t + 1) * kstep;
            const char* a2 = last ? nA : cA + (size_t)(t + 2) * kstep; const char* b2 = last ? nB : cB + (size_t)(t + 2) * kstep;
            const char* a3 = a2 + kstep; const char* b3 = b2 + kstep;
            if (last && has_next) S.a_ready(nxt);
            if constexpr (SP2) {
            PG8_LDB(B0, 0, 0); PG8_LDB(B1, 0, 1); PG8_SCHED; PG8_LDA(At, 0, 0); PG8_STAGE(PG8_SA(1, 1), a1 + hstep, voffA);
            PG8_WAIT_V(8); PG8_WAIT_L(0); PG8_BAR; PG8_MMA(0, 0, At, B0); PG8_MMA(0, 1, At, B1); PG8_BAR; PG8_SCHED;
            PG8_LDA(At, 0, 1); PG8_STAGE(PG8_SB(0, 0), b2, voffB); PG8_STAGE(PG8_SB(0, 1), b2 + hstep, voffB); PG8_STAGE(PG8_SA(0, 0), a2, voffA);
            PG8_WAIT_V(8); PG8_WAIT_L(0); PG8_BAR; PG8_MMA(1, 0, At, B0); PG8_MMA(1, 1, At, B1); PG8_BAR; PG8_SCHED;
            PG8_LDB(B0, 1, 0); PG8_LDB(B1, 1, 1); PG8_SCHED; PG8_LDA(At, 1, 0); PG8_STAGE(PG8_SA(0, 1), a2 + hstep, voffA);
            PG8_WAIT_V(8); PG8_WAIT_L(0); PG8_BAR; PG8_MMA(0, 0, At, B0); PG8_MMA(0, 1, At, B1); PG8_BAR; PG8_SCHED;
            PG8_LDA(At, 1, 1); PG8_STAGE(PG8_SB(1, 0), b3, voffB); PG8_STAGE(PG8_SB(1, 1), b3 + hstep, voffB); PG8_STAGE(PG8_SA(1, 0), a3, voffA);
            PG8_WAIT_V(8); PG8_WAIT_L(0); PG8_BAR; PG8_MMA(1, 0, At, B0); PG8_MMA(1, 1, At, B1); PG8_BAR; PG8_SCHED;
            } else {
            PG8_LDB(B0, 0, 0); PG8_SCHED; PG8_LDA(At, 0, 0); PG8_STAGE(PG8_SA(1, 1), a1 + hstep, voffA);
            PG8_WAIT_L(8); PG8_BAR; PG8_WAIT_L(0); PG8_MMA(0, 0, At, B0); PG8_BAR; PG8_SCHED;
            PG8_LDB(B1, 0, 1); PG8_STAGE(PG8_SB(0, 0), b2, voffB);
            PG8_BAR; PG8_WAIT_L(0); PG8_MMA(0, 1, At, B1); PG8_BAR;
            PG8_LDA(At, 0, 1); PG8_STAGE(PG8_SA(0, 0), a2, voffA);
            PG8_BAR; PG8_WAIT_L(0); PG8_MMA(1, 0, At, B0); PG8_BAR; PG8_SCHED;
            PG8_STAGE(PG8_SB(0, 1), b2 + hstep, voffB);
            PG8_WAIT_V(6); PG8_BAR; PG8_MMA(1, 1, At, B1); PG8_BAR;
            PG8_LDB(B0, 1, 0); PG8_SCHED; PG8_LDA(At, 1, 0); PG8_STAGE(PG8_SA(0, 1), a2 + hstep, voffA);
            PG8_WAIT_L(8); PG8_BAR; PG8_WAIT_L(0); PG8_MMA(0, 0, At, B0); PG8_BAR; PG8_SCHED;
            PG8_LDB(B1, 1, 1); PG8_STAGE(PG8_SB(1, 0), b3, voffB);
            PG8_BAR; PG8_WAIT_L(0); PG8_MMA(0, 1, At, B1); PG8_BAR;
            PG8_LDA(At, 1, 1); PG8_STAGE(PG8_SA(1, 0), a3, voffA);
            PG8_BAR; PG8_WAIT_L(0); PG8_MMA(1, 0, At, B0); PG8_BAR; PG8_SCHED;
            PG8_STAGE(PG8_SB(1, 1), b3 + hstep, voffB);
            PG8_WAIT_V(6); PG8_BAR; PG8_MMA(1, 1, At, B1); PG8_BAR;
            }
        }
        if constexpr (ALIGN_EPI) { if (wr == 0) PG8_BAR; }
        if constexpr (!Epi::AFTER_DRAIN) { E(acc, cur, wr, wc, fr, fq); S.done(cur); }
        if (!has_next) break;
#pragma unroll
        for (int a = 0; a < 2; ++a)
#pragma unroll
            for (int b = 0; b < 2; ++b)
#pragma unroll
                for (int m = 0; m < 4; ++m)
#pragma unroll
                    for (int n = 0; n < 2; ++n) acc[a][b][m][n] = (f32x4){0.f, 0.f, 0.f, 0.f};
        cur = nxt; cA = nA; cB = nB; ++ui;
        if constexpr (ALIGN_EPI) { if (wr == 1) PG8_BAR; }
    }
    PG8_WAIT_V(0);
    if constexpr (!ALIGN_EPI) { if (wr == 0) PG8_BAR; }
    PG8_BAR;
    if constexpr (Epi::AFTER_DRAIN) { E.fused(acc, cur, wr, wc, fr, fq, lds, wid, lane); S.done(cur); }
#undef PG8_SA
#undef PG8_SB
#undef PG8_STAGE
#undef PG8_LDA
#undef PG8_LDB
#undef PG8_MMA
#undef PG8_WAIT_V
#undef PG8_WAIT_L
#undef PG8_BAR
#undef PG8_SCHED
}
}

constexpr int NWAVES = 8;
constexpr int BATCH = 4, SEQ = 8192, D = 1024, M = BATCH * SEQ;
constexpr int BW = 512, NQKV = 4608, N1 = 5120, N2 = 3072, INW = 8192, QKVP = 1536, NGH = 24, NKEY = 129, BIASP = 132;
constexpr float RMS_EPS = 1e-6f;
constexpr float LOG2E = 1.4426950408889634f;
constexpr float C2 = 0.125f * LOG2E;
#ifndef MK_ONE_LAUNCH
#define MK_ONE_LAUNCH 1
#endif
constexpr int NPHASE = 7;

constexpr size_t MiB = 1u << 20;
constexpr size_t WS_CTL = 0, CTL_ZERO_BYTES = 1 * MiB;
constexpr size_t WS_WT1 = 2 * MiB;
constexpr size_t WS_WT2 = 12 * MiB;
constexpr size_t WS_WAT = 18 * MiB, WS_WBT = 19 * MiB, WS_WOT = 20 * MiB;
constexpr size_t WS_BIAS = 22 * MiB;
constexpr size_t WS_LSE = 23 * MiB;
constexpr size_t WS_Q = 32 * MiB, WS_K = 128 * MiB, WS_V = 224 * MiB;
constexpr size_t WS_AP = 320 * MiB;
constexpr size_t WS_MIX = 352 * MiB;
constexpr size_t WS_XN = 384 * MiB;
constexpr size_t WS_UA = 128 * MiB, WS_UB = 160 * MiB, WS_G = 192 * MiB;
constexpr size_t WS_MRG = 320 * MiB;
constexpr size_t WS_END = 448 * MiB;
constexpr int CW_BAR = 4096;

constexpr int RING_OFF = 0, RING_BYTES = 131072;
constexpr int LDSCTL_OFF = 139264, MISC_OFF = LDSCTL_OFF + 320;
constexpr int LDS_BYTES = 147456;

static_assert(WS_V - WS_K == WS_K - WS_Q, "Q|K|V equally spaced");
#define GAS __attribute__((address_space(1)))
#define LAS __attribute__((address_space(3)))
typedef unsigned short bf16;
typedef unsigned v4u __attribute__((ext_vector_type(4)));
typedef float f32x4 __attribute__((ext_vector_type(4)));
typedef short bf16x8 __attribute__((ext_vector_type(8)));
typedef GAS unsigned gu32;
typedef GAS unsigned long long gu64;
#define RLX_AGENT __ATOMIC_RELAXED, __HIP_MEMORY_SCOPE_AGENT
#define LDS_WAIT() asm volatile("s_waitcnt lgkmcnt(0)" ::: "memory")
#define VM_WAIT() asm volatile("s_waitcnt vmcnt(0)" ::: "memory")
__device__ __forceinline__ unsigned long long rt() { return __builtin_amdgcn_s_memrealtime(); }
__device__ __forceinline__ unsigned f2bf(float f) { unsigned u = __builtin_bit_cast(unsigned, f); return (u + 0x7fffu + ((u >> 16) & 1u)) >> 16; }
__device__ __forceinline__ unsigned pk2(float lo, float hi) { return f2bf(lo) | (f2bf(hi) << 16); }

#define XB_TMO      128
#define XB_XCNT(j)  (256  + 64 * (j))
#define XB_XSUB(j)  (1280 + 64 * (j))
#define XB_XGEN(j)  (2304 + 64 * (j))
#define XB_TOP      3328
#define XB_TOPGEN   3392
#define XCD_BAR_WORDS 3456
#define XB_SPIN_CAP (1u << 18)

__device__ __forceinline__ unsigned xb_ld(unsigned* p)              { return __hip_atomic_load(p, __ATOMIC_RELAXED, __HIP_MEMORY_SCOPE_AGENT); }
__device__ __forceinline__ unsigned xb_add(unsigned* p, unsigned v) { return __hip_atomic_fetch_add(p, v, __ATOMIC_RELAXED, __HIP_MEMORY_SCOPE_AGENT); }
__device__ __forceinline__ unsigned xb_xcc_id() { return (unsigned)__builtin_amdgcn_s_getreg((3 << 11) | 20) & 0xFu; }
#define XB_SPIN(cond, bar) do { unsigned _sp = 0; while (cond) { __builtin_amdgcn_s_sleep(1); \
    if ((++_sp & 255u) == 0u) { if (xb_ld(&(bar)[XB_TMO])) break; if (_sp > XB_SPIN_CAP) { atomicAdd(&(bar)[XB_TMO], 1u); break; } } } } while (0)

struct XcdBarrier {
    unsigned* bar; unsigned x;
    volatile LAS unsigned* st;
};

__device__ __forceinline__ XcdBarrier xcd_barrier_post(unsigned* bar, volatile LAS unsigned* st) {
    XcdBarrier b; b.bar = bar; b.x = xb_xcc_id(); b.st = st;
    if (threadIdx.x == 0) (void)xb_add(&bar[XB_XCNT(b.x)], 1u);
    return b;
}
__device__ __forceinline__ void xcd_barrier_complete(unsigned* bar, unsigned x, unsigned& nloc, unsigned& nx) {
    const unsigned G = gridDim.x * gridDim.y * gridDim.z;
    unsigned sum, cnt, mine, sp = 0u;
    for (;;) {
        sum = 0u; cnt = 0u; mine = 0u;
#pragma unroll
        for (unsigned j = 0; j < 16; ++j) { const unsigned c = xb_ld(&bar[XB_XCNT(j)]); sum += c; cnt += (c > 0u) ? 1u : 0u; mine = (j == x) ? c : mine; }
        if (sum == G) break;
        __builtin_amdgcn_s_sleep(1);
        if ((++sp & 255u) == 0u) { if (xb_ld(&bar[XB_TMO])) break; if (sp > XB_SPIN_CAP) { atomicAdd(&bar[XB_TMO], 1u); break; } }
    }
    nloc = mine > 0u ? mine : 1u; nx = cnt > 0u ? cnt : 1u;
}

__device__ __forceinline__ void xcd_barrier(const XcdBarrier& b) {
    asm volatile("s_waitcnt vmcnt(0)" ::: "memory");
    __syncthreads();
    if (threadIdx.x == 0) {
        unsigned* bar = b.bar;
        __builtin_amdgcn_s_waitcnt(0);
        unsigned nloc = b.st[0], nx = b.st[1];
        if (nloc == 0u) { xcd_barrier_complete(bar, b.x, nloc, nx); b.st[0] = nloc; b.st[1] = nx; }
        const unsigned old = xb_add(&bar[XB_XSUB(b.x)], 1u);
        const unsigned gen = old / nloc;
        if (old + 1u == (gen + 1u) * nloc) {
            __builtin_amdgcn_fence(__ATOMIC_RELEASE, "agent");
            asm volatile("s_waitcnt vmcnt(0)" ::: "memory");
            const unsigned og = xb_add(&bar[XB_TOP], 1u);
            const unsigned tg = og / nx;
            if (og + 1u == (tg + 1u) * nx) xb_add(&bar[XB_TOPGEN], 1u);
            else XB_SPIN(xb_ld(&bar[XB_TOPGEN]) == tg, bar);
            __builtin_amdgcn_fence(__ATOMIC_ACQUIRE, "agent");
            xb_add(&bar[XB_XGEN(b.x)], 1u);
            asm volatile("s_waitcnt vmcnt(0)" ::: "memory");
        } else {
            XB_SPIN(xb_ld(&bar[XB_XGEN(b.x)]) == gen, bar);
            __builtin_amdgcn_fence(__ATOMIC_ACQUIRE, "agent");
            asm volatile("s_waitcnt vmcnt(0)" ::: "memory");
        }
    }
    __syncthreads();
}

struct Frame {
    LAS unsigned char* lds;
    int tid, lane, wave;
    int vcu, G;
    const float *x, *norm_gain, *w_in, *b_gate, *rel_bias, *w_pool, *pool_scale, *w_proj_a, *w_proj_b, *w_out, *final_gain;
    float* out;
    bf16 *Wt1, *Wt2, *Wat, *Wbt, *Wot;
    float *BIAS, *LSE;
    bf16 *Qb, *Kb, *Vb, *AP, *MIX, *XN, *UA, *UB, *GG, *MRG;
};
__device__ __forceinline__ float wave_sum(float v) {
#pragma unroll
    for (int o = 1; o < 64; o <<= 1) v += __shfl_xor(v, o);
    return v;
}
__device__ __forceinline__ float wave_max(float v) {
#pragma unroll
    for (int o = 1; o < 64; o <<= 1) v = fmaxf(v, __shfl_xor(v, o));
    return v;
}
__device__ __forceinline__ float bf2f(unsigned short b) { return __uint_as_float(((unsigned)b) << 16); }
__device__ __forceinline__ float blo(unsigned w) { return __uint_as_float(w << 16); }
__device__ __forceinline__ float bhi(unsigned w) { return __uint_as_float(w & 0xffff0000u); }

__device__ __forceinline__ void p0_transpose_item(const float* W, int ldw, int col0, int ncols, int K, const float* gain, bf16* WT, int row_off, LAS float* scr, int item, int lane) {
    const int nblk = ncols / 32, kb = item / nblk, nb = item % nblk, k0 = 64 * kb, n0 = 32 * nb;
#pragma unroll 8
    for (int i = 0; i < 32; ++i) { const int kk = 2 * i + (lane >> 5); float v = W[(size_t)(k0 + kk) * ldw + col0 + n0 + (lane & 31)]; if (gain) v *= gain[k0 + kk]; scr[kk * 33 + (lane & 31)] = v; }
    LDS_WAIT(); asm volatile("" ::: "memory");
    const int c = lane & 7;
#pragma unroll
    for (int j = 0; j < 4; ++j) { const int n = (lane >> 3) + 8 * j; const LAS float* s = scr + (8 * c) * 33 + n;
        v4u o; o.x = pk2(s[0 * 33], s[1 * 33]); o.y = pk2(s[2 * 33], s[3 * 33]); o.z = pk2(s[4 * 33], s[5 * 33]); o.w = pk2(s[6 * 33], s[7 * 33]);
        *(GAS v4u*)(WT + (size_t)(row_off + n0 + n) * K + k0 + 8 * c) = o; }
    LDS_WAIT(); asm volatile("" ::: "memory");
}
__device__ __forceinline__ void rms_row_to_bf16(const float* xrow, bf16* orow, int lane) {
    const GAS f32x4* xr = (const GAS f32x4*)xrow + lane;
    f32x4 v[4]; float s = 0.f;
#pragma unroll
    for (int j = 0; j < 4; ++j) { v[j] = xr[64 * j]; s += (v[j].x * v[j].x + v[j].y * v[j].y) + (v[j].z * v[j].z + v[j].w * v[j].w); }
    const float r = 1.0f / sqrtf(wave_sum(s) * (1.f / D) + RMS_EPS);
    GAS unsigned long long* o8 = (GAS unsigned long long*)orow + lane;
#pragma unroll
    for (int j = 0; j < 4; ++j) o8[64 * j] = (unsigned long long)pk2(v[j].x * r, v[j].y * r) | ((unsigned long long)pk2(v[j].z * r, v[j].w * r) << 32);
}
__device__ __forceinline__ int t5_bucket(int rel) {
    const int nb = 16, max_exact = 8;
    const int ret = (rel > 0) ? nb : 0;
    const int n = rel < 0 ? -rel : rel;
    const float nf = (float)(n > 1 ? n : 1);
    int large = max_exact + (int)(logf(nf / (float)max_exact) / logf(1024.0f / (float)max_exact) * (float)(nb - max_exact));
    large = large < nb - 1 ? large : nb - 1;
    return ret + (n < max_exact ? n : large);
}
__device__ __forceinline__ void p0_prologue(Frame& F) {
    {
        LAS float* tile = (LAS float*)(F.lds + RING_OFF);
        for (int task = F.vcu; task < 16 * 4 * 4; task += F.G) {
            const int kb = task >> 4, gp = (task >> 2) & 3, dq = task & 3;
            __syncthreads();
#pragma unroll
            for (int i = 0; i < 16; ++i) { const int e = F.tid + 512 * i, kk = e >> 7, c = e & 127; tile[kk * 129 + c] = F.w_in[(size_t)(kb * 64 + kk) * INW + gp * 128 + c]; }
            __syncthreads();
            const int k = kb * 64 + F.lane; float a[4] = {0.f, 0.f, 0.f, 0.f}; const int d0 = dq * 32 + F.wave * 4;
            const float* wp = F.w_pool + (size_t)gp * 16384 + d0;
            for (int c = 0; c < 128; ++c) { const float t = tile[F.lane * 129 + c];
#pragma unroll
                for (int i = 0; i < 4; ++i) a[i] += t * wp[c * 128 + i]; }
            const float gk = F.norm_gain[k];
#pragma unroll
            for (int i = 0; i < 4; ++i) { const int cp = gp * 128 + d0 + i; F.Wt1[(size_t)(NQKV + cp) * D + k] = (bf16)f2bf(a[i] * gk * F.pool_scale[cp]); }
        }
        __syncthreads();
    }
    LAS float* scr = (LAS float*)(F.lds + RING_OFF + F.wave * 16384);
    const int gw = F.vcu * NWAVES + F.wave, NGW = F.G * NWAVES;
    constexpr int I_QKV = (D / 64) * (NQKV / 32), I_AG = (D / 64) * (BW / 32), I_GL = (D / 64) * (2 * D / 32), I_PA = (BW / 64) * (D / 32), I_WO = (D / 64) * (D / 32);
    constexpr int NITEMS = I_QKV + 2 * I_AG + I_GL + 2 * I_PA + I_WO;
    for (int it = gw; it < NITEMS; it += NGW) {
        int r = it;
        if (r < I_QKV) { p0_transpose_item(F.w_in, INW, 1024, NQKV, D, F.norm_gain, F.Wt1, 0, scr, r, F.lane); continue; } r -= I_QKV;
        if (r < I_AG)  { p0_transpose_item(F.w_in, INW, 512, BW, D, F.norm_gain, F.Wt2, 0, scr, r, F.lane); continue; } r -= I_AG;
        if (r < I_AG)  { p0_transpose_item(F.w_in, INW, 5632, BW, D, F.norm_gain, F.Wt2, 512, scr, r, F.lane); continue; } r -= I_AG;
        if (r < I_GL)  { p0_transpose_item(F.w_in, INW, 6144, 2 * D, D, F.norm_gain, F.Wt2, 1024, scr, r, F.lane); continue; } r -= I_GL;
        if (r < I_PA)  { p0_transpose_item(F.w_proj_a, D, 0, D, BW, nullptr, F.Wat, 0, scr, r, F.lane); continue; } r -= I_PA;
        if (r < I_PA)  { p0_transpose_item(F.w_proj_b, D, 0, D, BW, nullptr, F.Wbt, 0, scr, r, F.lane); continue; } r -= I_PA;
        p0_transpose_item(F.w_out, D, 0, D, D, nullptr, F.Wot, 0, scr, r, F.lane);
    }
    for (int m = gw; m < M; m += NGW) rms_row_to_bf16(F.x + (size_t)m * D, F.XN + (size_t)m * D, F.lane);
    for (int idx = (int)blockIdx.x * 512 + F.tid; idx < NGH * BIASP; idx += F.G * 512) {
        const int gh = idx / BIASP, j = idx % BIASP, g = gh >> 3; const int dil = (g == 0) ? 1 : ((g == 1) ? 4 : 16);
        float v = 0.f; if (j < NKEY) v = F.rel_bias[t5_bucket((j - 64) * dil) * NGH + gh] * LOG2E;
        F.BIAS[idx] = v;
    }
}

__device__ __forceinline__ void p2_attention_simple(Frame& F) {
    LAS float* pbuf = (LAS float*)(F.lds + RING_OFF + F.wave * 1024);
    const int gw = F.vcu * NWAVES + F.wave, NGW = F.G * NWAVES, lane = F.lane;
    for (int task = gw; task < M * NGH; task += NGW) {
        const int t = task / NGH, gh = task - t * NGH, g = gh >> 3, h = gh & 7;
        const int pos = t & (SEQ - 1), dil = (g == 0) ? 1 : ((g == 1) ? 4 : 16);
        const size_t hoff = (size_t)g * 512 + h * 64;
        bf16* qrow = F.Qb + (size_t)t * QKVP + hoff;
        float q[64];
#pragma unroll
        for (int i = 0; i < 8; ++i) { const v4u w = *(const GAS v4u*)(qrow + 8 * i);
            q[8 * i + 0] = blo(w.x); q[8 * i + 1] = bhi(w.x); q[8 * i + 2] = blo(w.y); q[8 * i + 3] = bhi(w.y); q[8 * i + 4] = blo(w.z); q[8 * i + 5] = bhi(w.z); q[8 * i + 6] = blo(w.w); q[8 * i + 7] = bhi(w.w); }
        float s[3];
#pragma unroll
        for (int jj = 0; jj < 3; ++jj) {
            const int j = lane + 64 * jj, kpos = pos + (j - 64) * dil; const bool valid = (j < NKEY) && (kpos >= 0) && (kpos < SEQ);
            float dot = -INFINITY;
            if (valid) { const bf16* krow = F.Kb + (size_t)(t - pos + kpos) * QKVP + hoff; dot = 0.f;
#pragma unroll
                for (int i = 0; i < 8; ++i) { const v4u w = *(const GAS v4u*)(krow + 8 * i);
                    dot += q[8 * i + 0] * blo(w.x) + q[8 * i + 1] * bhi(w.x) + q[8 * i + 2] * blo(w.y) + q[8 * i + 3] * bhi(w.y) + q[8 * i + 4] * blo(w.z) + q[8 * i + 5] * bhi(w.z) + q[8 * i + 6] * blo(w.w) + q[8 * i + 7] * bhi(w.w); }
                dot += F.BIAS[gh * BIASP + j]; }
            s[jj] = dot;
        }
        const float mx = wave_max(fmaxf(fmaxf(s[0], s[1]), s[2]));
        float lsum = 0.f;
#pragma unroll
        for (int jj = 0; jj < 3; ++jj) { const float p = __builtin_amdgcn_exp2f(s[jj] - mx); pbuf[lane + 64 * jj] = p; lsum += p; }
        lsum = wave_sum(lsum);
        LDS_WAIT(); asm volatile("" ::: "memory");
        float o = 0.f;
        for (int j = 0; j < NKEY; ++j) { const int kpos = pos + (j - 64) * dil;
            if (kpos >= 0 && kpos < SEQ) o += pbuf[j] * bf2f(F.Vb[(size_t)(t - pos + kpos) * QKVP + hoff + lane]); }
        LDS_WAIT(); asm volatile("" ::: "memory");
        qrow[lane] = (bf16)f2bf(o / lsum);
        if (lane == 0) F.LSE[(size_t)t * NGH + gh] = mx + log2f(lsum);
    }
}
__device__ __forceinline__ void p2_pool(Frame& F) {
    const int gw = F.vcu * NWAVES + F.wave, NGW = F.G * NWAVES, lane = F.lane;
    const int half = 1 << (lane >> 4);
    for (int t = gw; t < M; t += NGW) {
        const int pos = t & (SEQ - 1);
        const bf16* base = F.AP + (size_t)(t - pos) * BW + lane * 8;
        float acc[8] = {0.f, 0.f, 0.f, 0.f, 0.f, 0.f, 0.f, 0.f}; int cnt = 0;
#pragma unroll
        for (int j = 0; j < 16; ++j) { const int row = pos - half + j;
            if (j < 2 * half && row >= 0 && row < SEQ) { const v4u w = *(const GAS v4u*)(base + (size_t)row * BW); ++cnt;
                acc[0] += blo(w.x); acc[1] += bhi(w.x); acc[2] += blo(w.y); acc[3] += bhi(w.y); acc[4] += blo(w.z); acc[5] += bhi(w.z); acc[6] += blo(w.w); acc[7] += bhi(w.w); } }
        const v4u cw = *(const GAS v4u*)(base + (size_t)pos * BW); const float fc = (float)cnt;
        v4u o; o.x = pk2(acc[0] / fc - blo(cw.x), acc[1] / fc - bhi(cw.x)); o.y = pk2(acc[2] / fc - blo(cw.y), acc[3] / fc - bhi(cw.y));
        o.z = pk2(acc[4] / fc - blo(cw.z), acc[5] / fc - bhi(cw.z)); o.w = pk2(acc[6] / fc - blo(cw.w), acc[7] / fc - bhi(cw.w));
        *(GAS v4u*)(F.MIX + (size_t)t * BW + lane * 8) = o;
    }
}
__device__ __forceinline__ void p6_final_norm(Frame& F) {
    const int gw = F.vcu * NWAVES + F.wave, NGW = F.G * NWAVES, lane = F.lane;
    f32x4 gn[4];
#pragma unroll
    for (int j = 0; j < 4; ++j) gn[j] = ((const GAS f32x4*)F.final_gain)[lane + 64 * j];
    for (int m = gw; m < M; m += NGW) {
        GAS f32x4* yr = (GAS f32x4*)(F.out + (size_t)m * D) + lane;
        f32x4 v[4]; float s = 0.f;
#pragma unroll
        for (int j = 0; j < 4; ++j) { v[j] = yr[64 * j]; s += (v[j].x * v[j].x + v[j].y * v[j].y) + (v[j].z * v[j].z + v[j].w * v[j].w); }
        const float r = 1.0f / sqrtf(wave_sum(s) * (1.f / D) + RMS_EPS);
#pragma unroll
        for (int j = 0; j < 4; ++j) yr[64 * j] = v[j] * r * gn[j];
    }
}


namespace att {
typedef short bf16x8 __attribute__((ext_vector_type(8)));
typedef short s16x4 __attribute__((ext_vector_type(4)));
typedef short v4i16_t __attribute__((ext_vector_type(4)));
typedef float f32x16 __attribute__((ext_vector_type(16)));
constexpr int KR = 384, L_K = 0, L_V = KR * 128, L_VH = KR * 64, L_T = 2 * KR * 128, L_WS = L_T + 4096, L_OST = L_WS + 8 * 256, L_END = L_OST + 8 * 4096;
constexpr int NUNITS = BATCH * 3 * 8 * 32;
__device__ __forceinline__ int crow(int r, int hi) { return (r & 3) + 8 * (r >> 2) + 4 * hi; }
__device__ __forceinline__ s16x4 vtr(const LAS unsigned char* p) { return __builtin_bit_cast(s16x4, __builtin_amdgcn_ds_read_tr16_b64_v4i16((LAS v4i16_t*)p)); }
}
__device__ __forceinline__ void p2_attention_mfma(Frame& F) {
    using namespace att;
    const int tid = F.tid, lane = F.lane, w = F.wave, r32 = lane & 31, hi = lane >> 5;
    LAS unsigned char* lds = F.lds;
    const int upw = (NUNITS + F.G - 1) / F.G;
    for (int ui = 0; ui < upw; ++ui) {
        const int u = F.vcu * upw + ui; if (u >= NUNITS) break;
        const int x = u & 31, h = (u >> 5) & 7, bg = u >> 8, g = bg % 3, b = bg / 3, gh = g * 8 + h;
        const int dil = (g == 0) ? 1 : ((g == 1) ? 4 : 16), SD = SEQ / dil;
        const int rres = (g == 0) ? 0 : ((g == 1) ? (x >> 3) : (x >> 1)), qt = (g == 0) ? x : ((g == 1) ? (x & 7) : (x & 1));
        const int i0 = qt * 256;
        const size_t rowbase = (size_t)b * SEQ + rres; const int hoff = g * 512 + h * 64;
        const size_t rstride = (size_t)dil * QKVP;
        __syncthreads();
        const bf16* Kg = F.Kb + rowbase * QKVP + hoff; const bf16* Vg = F.Vb + rowbase * QKVP + hoff;
#pragma unroll
        for (int j = 0; j < 6; ++j) { const int p = w + 8 * j, R = 8 * p + (lane >> 3); int i = i0 - 64 + R; i = i < 0 ? 0 : (i > SD - 1 ? SD - 1 : i);
            const int chunk = (lane & 7) ^ ((R >> 1) & 7);
            __builtin_amdgcn_global_load_lds((const unsigned*)(Kg + (size_t)i * rstride + chunk * 8), (LAS unsigned*)(lds + L_K + p * 1024), 16, 0, 0); }
#pragma unroll
        for (int j = 0; j < 6; ++j) { const int pp = w + 8 * j, dh = pp / 24, pv = pp - 24 * dh, R = 16 * pv + (lane >> 2); int i = i0 - 64 + R; i = i < 0 ? 0 : (i > SD - 1 ? SD - 1 : i);
            __builtin_amdgcn_global_load_lds((const unsigned*)(Vg + (size_t)i * rstride + dh * 32 + (lane & 3) * 8), (LAS unsigned*)(lds + L_V + dh * L_VH + pv * 1024), 16, 0, 0); }
#pragma unroll
        for (int k = 0; k < 2; ++k) { const int idx = tid + 512 * k, s = idx >> 8, n = idx & 255, j = n + s - 32;
            float v = -INFINITY; if (j >= 0 && j < NKEY) v = F.BIAS[gh * BIASP + j];
            ((LAS float*)(lds + L_T))[idx] = v; }
        const int iq = i0 + 32 * w + r32;
        bf16* Qrow = F.Qb + (rowbase + (size_t)iq * dil) * QKVP + hoff;
        bf16x8 qr[4];
#pragma unroll
        for (int kk = 0; kk < 4; ++kk) qr[kk] = *(const GAS bf16x8*)(Qrow + kk * 16 + hi * 8);
        asm volatile("s_waitcnt vmcnt(0) lgkmcnt(0)" ::: "memory");
        __syncthreads();
        f32x16 p[5];
        { const int s = (4 - (r32 & 3)) & 3; const LAS unsigned char* tb = lds + L_T + s * 1024 + (32 + 4 * hi - r32 - s) * 4;
#pragma unroll
          for (int kb = 0; kb < 5; ++kb) {
#pragma unroll
              for (int rr = 0; rr < 4; ++rr) { const f32x4 t4 = *(const LAS f32x4*)(tb + (32 * kb + 8 * rr) * 4); p[kb][4 * rr + 0] = t4[0]; p[kb][4 * rr + 1] = t4[1]; p[kb][4 * rr + 2] = t4[2]; p[kb][4 * rr + 3] = t4[3]; }
              const int R = 32 * w + 32 * kb + r32; const LAS unsigned char* kp = lds + L_K + R * 128; const int sw = (R >> 1) & 7;
#pragma unroll
              for (int kk = 0; kk < 4; ++kk) { const bf16x8 kf = *(const LAS bf16x8*)(kp + (((2 * kk + hi) ^ sw) << 4)); p[kb] = __builtin_amdgcn_mfma_f32_32x32x16_bf16(kf, qr[kk], p[kb], 0, 0, 0); }
          } }
        if (i0 == 0 || i0 + 256 == SD) {
#pragma unroll
            for (int kb = 0; kb < 5; ++kb)
#pragma unroll
                for (int r = 0; r < 16; ++r) { const int ki = i0 + 32 * w - 64 + 32 * kb + crow(r, hi); if (ki < 0 || ki >= SD) p[kb][r] = -INFINITY; }
        }
        float mx = p[0][0];
#pragma unroll
        for (int kb = 0; kb < 5; ++kb)
#pragma unroll
            for (int r = 0; r < 16; ++r) mx = fmaxf(mx, p[kb][r]);
        { auto rr = __builtin_amdgcn_permlane32_swap(__float_as_uint(mx), __float_as_uint(mx), false, false); mx = fmaxf(__uint_as_float(rr[0]), __uint_as_float(rr[1])); }
        float ls = 0.f;
#pragma unroll
        for (int kb = 0; kb < 5; ++kb)
#pragma unroll
            for (int r = 0; r < 16; ++r) { const float e = __builtin_amdgcn_exp2f(p[kb][r] - mx); p[kb][r] = e; ls += e; }
        { auto rr = __builtin_amdgcn_permlane32_swap(__float_as_uint(ls), __float_as_uint(ls), false, false); ls = __uint_as_float(rr[0]) + __uint_as_float(rr[1]); }
        f32x16 o[2]; o[0] = f32x16{}; o[1] = f32x16{};
        const LAS unsigned char* vb = lds + L_V + (32 * w + 4 * hi + ((lane & 15) >> 2)) * 64 + ((lane >> 4) & 1) * 32 + (lane & 3) * 8;
#pragma unroll
        for (int kb = 0; kb < 5; ++kb)
#pragma unroll
            for (int s = 0; s < 2; ++s) {
                v4u pw; pw.x = pg8::cvt_pk_bf16(p[kb][8 * s + 0], p[kb][8 * s + 1]); pw.y = pg8::cvt_pk_bf16(p[kb][8 * s + 2], p[kb][8 * s + 3]); pw.z = pg8::cvt_pk_bf16(p[kb][8 * s + 4], p[kb][8 * s + 5]); pw.w = pg8::cvt_pk_bf16(p[kb][8 * s + 6], p[kb][8 * s + 7]);
                const bf16x8 pa = __builtin_bit_cast(bf16x8, pw);
#pragma unroll
                for (int d0 = 0; d0 < 2; ++d0) { const LAS unsigned char* vp = vb + d0 * L_VH + (32 * kb + 16 * s) * 64;
                    const s16x4 lo = vtr(vp), hh = vtr(vp + 512);
                    const bf16x8 vf = (bf16x8){lo[0], lo[1], lo[2], lo[3], hh[0], hh[1], hh[2], hh[3]};
                    o[d0] = __builtin_amdgcn_mfma_f32_32x32x16_bf16(pa, vf, o[d0], 0, 0, 0); }
            }
        LAS float* wsf = (LAS float*)(lds + L_WS + w * 256);
        if (hi == 0) { wsf[r32] = __builtin_amdgcn_rcpf(ls); F.LSE[(rowbase + (size_t)iq * dil) * NGH + gh] = mx + __builtin_amdgcn_logf(ls); }
        asm volatile("s_waitcnt lgkmcnt(0)" ::: "memory");
        LAS unsigned short* stg = (LAS unsigned short*)(lds + L_OST + w * 4096);
#pragma unroll
        for (int r = 0; r < 16; ++r) { const int orow = crow(r, hi); const float rl = wsf[orow];
#pragma unroll
            for (int d0 = 0; d0 < 2; ++d0) stg[orow * 64 + d0 * 32 + r32] = (unsigned short)f2bf(o[d0][r] * rl); }
        asm volatile("s_waitcnt lgkmcnt(0)" ::: "memory");
#pragma unroll
        for (int i = 0; i < 4; ++i) { const int row = i * 8 + (lane >> 3), ch = lane & 7; const v4u v = *(const LAS v4u*)(stg + row * 64 + ch * 8);
            *(GAS v4u*)(F.Qb + (rowbase + (size_t)(i0 + 32 * w + row) * dil) * QKVP + hoff + ch * 8) = v; }
    }
}
static_assert(att::L_END <= LDSCTL_OFF, "attention scratch vs LDS control words");

struct Args { const float* in[11]; float* out; unsigned char* ws; int ph_lo, ph_hi; };
__global__ void __launch_bounds__(NWAVES * 64, 2) skel_fwd(Args args) {
    extern __shared__ __attribute__((aligned(16))) unsigned char lds[];
    Frame F;
    F.lds = (LAS unsigned char*)lds;
    F.tid = threadIdx.x; F.lane = F.tid & 63; F.wave = __builtin_amdgcn_readfirstlane(F.tid >> 6);
    F.G = gridDim.x; { const int bx = blockIdx.x; F.vcu = (F.G % 8 == 0) ? (bx % 8) * (F.G / 8) + bx / 8 : bx; }
    unsigned char* ws = args.ws;
    F.x = args.in[0]; F.norm_gain = args.in[1]; F.w_in = args.in[2]; F.b_gate = args.in[3]; F.rel_bias = args.in[4]; F.w_pool = args.in[5]; F.pool_scale = args.in[6];
    F.w_proj_a = args.in[7]; F.w_proj_b = args.in[8]; F.w_out = args.in[9]; F.final_gain = args.in[10]; F.out = args.out;
    F.Wt1 = (bf16*)(ws + WS_WT1); F.Wt2 = (bf16*)(ws + WS_WT2); F.Wat = (bf16*)(ws + WS_WAT); F.Wbt = (bf16*)(ws + WS_WBT); F.Wot = (bf16*)(ws + WS_WOT);
    F.BIAS = (float*)(ws + WS_BIAS); F.LSE = (float*)(ws + WS_LSE);
    F.Qb = (bf16*)(ws + WS_Q); F.Kb = (bf16*)(ws + WS_K); F.Vb = (bf16*)(ws + WS_V); F.AP = (bf16*)(ws + WS_AP); F.MIX = (bf16*)(ws + WS_MIX); F.XN = (bf16*)(ws + WS_XN);
    F.UA = (bf16*)(ws + WS_UA); F.UB = (bf16*)(ws + WS_UB); F.GG = (bf16*)(ws + WS_G); F.MRG = (bf16*)(ws + WS_MRG);
    for (int u = F.tid; u < (LDS_BYTES - LDSCTL_OFF) / 4; u += NWAVES * 64) ((LAS unsigned*)(F.lds + LDSCTL_OFF))[u] = 0u;
    __syncthreads();
    const int lo = args.ph_lo, hi = args.ph_hi;
    XcdBarrier bar; bar.bar = (unsigned*)(ws + WS_CTL) + CW_BAR; bar.x = 0; bar.st = nullptr;
    if (hi - lo > 1) bar = xcd_barrier_post((unsigned*)(ws + WS_CTL) + CW_BAR, (volatile LAS unsigned*)(F.lds + MISC_OFF) + 8);
#define IN(k) (lo <= (k) && (k) < hi)
#define SEAM(k) do { if (IN(k) && IN((k) + 1)) xcd_barrier(bar); } while (0)

    if (IN(0)) { p0_prologue(F); SEAM(0); }
    if (IN(1)) {
        pg8::Gemm g{F.XN, F.Wt1, M, N1, D}; pg8::StaticOrder S; S.init(M, N1, F.G, (int)blockIdx.x);
        pg8::EpiP1 E{F.Qb, (size_t)(WS_K - WS_Q) / 2, F.AP, C2};
        pg8::gemm_phase<pg8::EpiP1, pg8::StaticOrder, true, true>(F.lds + RING_OFF, g, S, E);
        SEAM(1);
    }
    if (IN(2)) { p2_attention_mfma(F); p2_pool(F); SEAM(2); }
    if (IN(3)) {
        pg8::Gemm g{F.XN, F.Wt2, M, N2, D}; pg8::StaticOrder S; S.init(M, N2, F.G, (int)blockIdx.x);
        pg8::EpiP3 E{F.MIX, F.Qb, F.LSE, F.b_gate, F.UA, F.UB, F.GG};
        pg8::gemm_phase<pg8::EpiP3, pg8::StaticOrder, true, true>(F.lds + RING_OFF, g, S, E);
        SEAM(3);
    }
    if (IN(4)) {
        { pg8::Gemm g{F.UA, F.Wat, M, D, BW}; pg8::StaticOrder S; S.init(M, D, F.G, (int)blockIdx.x);
          pg8::EpiP4<false> E{F.GG, F.MRG};
          pg8::gemm_phase<pg8::EpiP4<false>, pg8::StaticOrder, true, true>(F.lds + RING_OFF, g, S, E); }
        { pg8::Gemm g{F.UB, F.Wbt, M, D, BW}; pg8::StaticOrder S; S.init(M, D, F.G, (int)blockIdx.x);
          pg8::EpiP4<true> E{F.GG, F.MRG};
          pg8::gemm_phase<pg8::EpiP4<true>, pg8::StaticOrder, true, true>(F.lds + RING_OFF, g, S, E); }
        SEAM(4);
    }
    if (IN(5)) {
        pg8::Gemm g{F.MRG, F.Wot, M, D, D}; pg8::StaticOrder S; S.init(M, D, F.G, (int)blockIdx.x);
        pg8::EpiP5 E{F.x, F.out};
        pg8::gemm_phase<pg8::EpiP5, pg8::StaticOrder, true, true>(F.lds + RING_OFF, g, S, E);
        SEAM(5);
    }
    if (IN(6)) { p6_final_norm(F); }
#undef IN
#undef SEAM
}

extern "C" void kernel_launch(void* const* d_in, const int* in_sizes, int n_in, void* d_out, int out_size, void* d_ws, size_t ws_size, hipStream_t stream) {
    static int grid = 0;
    if (grid == 0) {
        if (n_in != 11 || in_sizes[0] != M * D || out_size != M * D || ws_size < WS_END) { fprintf(stderr, "kernel_launch: unexpected shapes (n_in %d, in0 %d, out %d, ws %zu); nothing launched\n", n_in, n_in > 0 ? in_sizes[0] : -1, out_size, ws_size); grid = -1; return; }
        int dev = 0, cus = 0, per_cu = 0;
        if (hipGetDevice(&dev) != hipSuccess || hipDeviceGetAttribute(&cus, hipDeviceAttributeMultiprocessorCount, dev) != hipSuccess) { grid = -1; return; }
        if (hipFuncSetAttribute((const void*)skel_fwd, hipFuncAttributeMaxDynamicSharedMemorySize, LDS_BYTES) != hipSuccess) { fprintf(stderr, "kernel_launch: hipFuncSetAttribute failed\n"); grid = -1; return; }
        if (hipOccupancyMaxActiveBlocksPerMultiprocessor(&per_cu, (const void*)skel_fwd, NWAVES * 64, LDS_BYTES) != hipSuccess || per_cu < 1) { fprintf(stderr, "kernel_launch: occupancy query reports %d\n", per_cu); }
        (void)hipGetLastError();
        grid = cus;
    }
    if (grid < 0) return;
    if (hipMemsetAsync((char*)d_ws + WS_CTL, 0, CTL_ZERO_BYTES, stream) != hipSuccess) return;
    Args a{};
    for (int i = 0; i < 11; ++i) a.in[i] = (const float*)d_in[i];
    a.out = (float*)d_out; a.ws = (unsigned char*)d_ws;
#if MK_ONE_LAUNCH
    a.ph_lo = 0; a.ph_hi = NPHASE;
    hipLaunchKernelGGL(skel_fwd, dim3(grid), dim3(NWAVES * 64), LDS_BYTES, stream, a);
#else
    for (int p = 0; p < NPHASE; ++p) { a.ph_lo = p; a.ph_hi = p + 1; hipLaunchKernelGGL(skel_fwd, dim3(grid), dim3(NWAVES * 64), LDS_BYTES, stream, a); }
#endif
}
```

```cpp
#include <hip/hip_runtime.h>
#include <cstdio>
#include <cstdint>
namespace pg8 {
#define PG8_LAS __attribute__((address_space(3)))
typedef unsigned short bf16_t;
typedef short bf16x8 __attribute__((ext_vector_type(8)));
typedef float f32x4 __attribute__((ext_vector_type(4)));
typedef unsigned u32x4 __attribute__((ext_vector_type(4)));
constexpr int BM = 256, BK = 64, HALF = 128, HTB = HALF * BK * 2  , STAGE_BYTES = 8 * HTB, NXCD = 8, WGM = 8;

__host__ __device__ __forceinline__ int lds_byte(int r, int c) { const int st = (r >> 4) * 2 + (c >> 5), rr = r & 15, cc = c & 31, ob = rr * 64 + cc * 2; return st * 1024 + (ob ^ (((ob >> 9) & 1) << 5)); }
__host__ __device__ __forceinline__ void stage_rc(int b, int& R, int& C) { const int st = b / 1024, sb = b % 1024, swz = sb ^ (((sb >> 9) & 1) << 5); R = (st >> 1) * 16 + swz / 64; C = (st & 1) * 32 + (swz % 64) / 2; }
__host__ __device__ __forceinline__ int perm32(int rho) { const int n = rho >> 4, i = rho & 15; return 8 * (i >> 2) + 4 * n + (i & 3); }

struct Unit { int pm, pn; };
struct Gemm { const bf16_t* A; const bf16_t* Bt; int M, N, K; };

struct StaticOrder {
    int nM, nN, nwg, G, c;
    __host__ __device__ void init(int M, int N, int G_, int c_) { nM = M / BM; nN = N / BM; nwg = nM * nN; G = G_; c = c_; }
    __host__ __device__ bool next(int i, Unit& u) const {
        const long L = (long)i * G + c; if (L >= nwg) return false;
        int wgid = (int)L; { const int q = nwg / NXCD, r = nwg % NXCD, xcd = wgid % NXCD, off = wgid / NXCD; wgid = (xcd < r ? xcd * (q + 1) : r * (q + 1) + (xcd - r) * q) + off; }
        const int nig = WGM * nN, gid = wgid / nig, fm = gid * WGM, gsz = (nM - fm) < WGM ? (nM - fm) : WGM;
        u.pm = fm + ((wgid % nig) % gsz); u.pn = (wgid % nig) / gsz; return true;
    }
    __device__ __forceinline__ void a_ready(const Unit&) const {}
    __device__ __forceinline__ void done(const Unit&) const {}
};
typedef float f32x2_t __attribute__((ext_vector_type(2))); typedef __bf16 bf16x2_t __attribute__((ext_vector_type(2)));
__device__ __forceinline__ unsigned cvt_pk_bf16(float lo, float hi) { f32x2_t v = {lo, hi}; bf16x2_t b = __builtin_convertvector(v, bf16x2_t); return __builtin_bit_cast(unsigned, b); }
__device__ __forceinline__ float bflo(unsigned w) { return __uint_as_float(w << 16); }
__device__ __forceinline__ float bfhi(unsigned w) { return __uint_as_float(w & 0xffff0000u); }
__device__ __forceinline__ float sigm(float x) { return __builtin_amdgcn_rcpf(1.0f + __builtin_amdgcn_exp2f(-1.4426950408889634f * x)); }
__device__ __forceinline__ u32x4 pack8(const f32x4 a, const f32x4 b) { u32x4 w; w.x = cvt_pk_bf16(a[0], a[1]); w.y = cvt_pk_bf16(a[2], a[3]); w.z = cvt_pk_bf16(b[0], b[1]); w.w = cvt_pk_bf16(b[2], b[3]); return w; }
__device__ __forceinline__ void unpack8(const u32x4 w, f32x4& a, f32x4& b) { a[0] = bflo(w.x); a[1] = bfhi(w.x); a[2] = bflo(w.y); a[3] = bfhi(w.y); b[0] = bflo(w.z); b[1] = bfhi(w.z); b[2] = bflo(w.w); b[3] = bfhi(w.w); }

struct EpiP1 {
    static constexpr bool PERM = true, AFTER_DRAIN = false;
    bf16_t* QKV; size_t tstride; bf16_t* AP; float qscale;
    __device__ __forceinline__ void operator()(const f32x4 (&acc)[2][2][4][2], const Unit& u, int wr, int wc, int fr, int fq) const {
        const int row0 = u.pm * BM + wr * 64 + fr;
        const bool isq = u.pn < 18; const int t = u.pn / 6;
        bf16_t* base = isq ? QKV + (size_t)t * tstride : AP;
        const int ldc = isq ? 1536 : 512, colt = isq ? (u.pn - 6 * t) * BM : (u.pn - 18) * BM;
        const float sc = (u.pn < 6) ? qscale : 1.f;
        const int col0 = colt + wc * 32 + 8 * fq;
#pragma unroll
        for (int ai = 0; ai < 2; ++ai)
#pragma unroll
            for (int m = 0; m < 4; ++m) { bf16_t* rowp = base + (size_t)(row0 + ai * HALF + m * 16) * ldc + col0;
#pragma unroll
                for (int bj = 0; bj < 2; ++bj) *(u32x4*)(rowp + bj * HALF) = pack8(acc[ai][bj][m][0] * sc, acc[ai][bj][m][1] * sc); }
    }
};
struct EpiP3 {
    static constexpr bool PERM = true, AFTER_DRAIN = false;
    const bf16_t* MIX; const bf16_t* ON; const float* LSE; const float* bgate; bf16_t* UA; bf16_t* UB; bf16_t* G;
    __device__ __forceinline__ void operator()(const f32x4 (&acc)[2][2][4][2], const Unit& u, int wr, int wc, int fr, int fq) const {
        const int row0 = u.pm * BM + wr * 64 + fr;
        if (u.pn < 2) {
            const int col0 = u.pn * BM + wc * 32 + 8 * fq;
#pragma unroll
            for (int ai = 0; ai < 2; ++ai)
#pragma unroll
                for (int m = 0; m < 4; ++m) { const size_t r = (size_t)(row0 + ai * HALF + m * 16);
#pragma unroll
                    for (int bj = 0; bj < 2; ++bj) { const int c = col0 + bj * HALF; f32x4 m0, m1; unpack8(*(const u32x4*)(MIX + r * 512 + c), m0, m1);
                        f32x4 v0 = acc[ai][bj][m][0], v1 = acc[ai][bj][m][1];
#pragma unroll
                        for (int i = 0; i < 4; ++i) { v0[i] = v0[i] * sigm(v0[i]) * m0[i]; v1[i] = v1[i] * sigm(v1[i]) * m1[i]; }
                        *(u32x4*)(UA + r * 512 + c) = pack8(v0, v1); } }
        } else if (u.pn < 4) {
            const int col0 = (u.pn - 2) * BM + wc * 32 + 8 * fq;
#pragma unroll
            for (int ai = 0; ai < 2; ++ai)
#pragma unroll
                for (int m = 0; m < 4; ++m) { const size_t r = (size_t)(row0 + ai * HALF + m * 16);
#pragma unroll
                    for (int bj = 0; bj < 2; ++bj) { const int c = col0 + bj * HALF, h = c >> 6;
                        const float l0 = LSE[r * 24 + h], l1 = LSE[r * 24 + 8 + h], l2 = LSE[r * 24 + 16 + h];
                        const float mx = fmaxf(fmaxf(l0, l1), l2);
                        float e0 = __builtin_amdgcn_exp2f(l0 - mx), e1 = __builtin_amdgcn_exp2f(l1 - mx), e2 = __builtin_amdgcn_exp2f(l2 - mx);
                        const float inv = __builtin_amdgcn_rcpf(e0 + e1 + e2); e0 *= inv; e1 *= inv; e2 *= inv;
                        f32x4 a0, a1, b0, b1, c0, c1;
                        unpack8(*(const u32x4*)(ON + r * 1536 + c), a0, a1); unpack8(*(const u32x4*)(ON + r * 1536 + 512 + c), b0, b1); unpack8(*(const u32x4*)(ON + r * 1536 + 1024 + c), c0, c1);
                        f32x4 v0 = acc[ai][bj][m][0], v1 = acc[ai][bj][m][1];
#pragma unroll
                        for (int i = 0; i < 4; ++i) { v0[i] = v0[i] * sigm(v0[i]) * (e0 * a0[i] + e1 * b0[i] + e2 * c0[i]); v1[i] = v1[i] * sigm(v1[i]) * (e0 * a1[i] + e1 * b1[i] + e2 * c1[i]); }
                        *(u32x4*)(UB + r * 512 + c) = pack8(v0, v1); } }
        } else {
            const int col0 = (u.pn - 4) * BM + wc * 32 + 8 * fq;
            f32x4 bv[2][2];
#pragma unroll
            for (int bj = 0; bj < 2; ++bj)
#pragma unroll
                for (int n = 0; n < 2; ++n) bv[bj][n] = *(const f32x4*)(bgate + col0 + bj * HALF + 4 * n);
#pragma unroll
            for (int ai = 0; ai < 2; ++ai)
#pragma unroll
                for (int m = 0; m < 4; ++m) { const size_t r = (size_t)(row0 + ai * HALF + m * 16);
#pragma unroll
                    for (int bj = 0; bj < 2; ++bj) { f32x4 v0 = acc[ai][bj][m][0] + bv[bj][0], v1 = acc[ai][bj][m][1] + bv[bj][1];
#pragma unroll
                        for (int i = 0; i < 4; ++i) { v0[i] = sigm(v0[i]); v1[i] = sigm(v1[i]); }
                        *(u32x4*)(G + r * 2048 + col0 + bj * HALF) = pack8(v0, v1); } }
        }
    }
};
template <bool SECOND> struct EpiP4 {
    static constexpr bool PERM = true, AFTER_DRAIN = false;
    const bf16_t* G; bf16_t* Y;
    __device__ __forceinline__ void operator()(const f32x4 (&acc)[2][2][4][2], const Unit& u, int wr, int wc, int fr, int fq) const {
        const int row0 = u.pm * BM + wr * 64 + fr, col0 = u.pn * BM + wc * 32 + 8 * fq;
#pragma unroll
        for (int ai = 0; ai < 2; ++ai)
#pragma unroll
            for (int m = 0; m < 4; ++m) { const size_t r = (size_t)(row0 + ai * HALF + m * 16);
#pragma unroll
                for (int bj = 0; bj < 2; ++bj) { const int c = col0 + bj * HALF; f32x4 g0, g1; unpack8(*(const u32x4*)(G + r * 2048 + (SECOND ? 1024 : 0) + c), g0, g1);
                    f32x4 v0 = acc[ai][bj][m][0] * g0, v1 = acc[ai][bj][m][1] * g1;
                    if (SECOND) { f32x4 y0, y1; unpack8(*(const u32x4*)(Y + r * 1024 + c), y0, y1); v0 += y0; v1 += y1; }
                    *(u32x4*)(Y + r * 1024 + c) = pack8(v0, v1); } }
    }
};
struct EpiP5 {
    static constexpr bool PERM = false, AFTER_DRAIN = false;
    const float* X; float* O;
    __device__ __forceinline__ void operator()(const f32x4 (&acc)[2][2][4][2], const Unit& u, int wr, int wc, int fr, int fq) const {
        const int row0 = u.pm * BM + wr * 64 + fr, col0 = u.pn * BM + wc * 32 + 4 * fq;
#pragma unroll
        for (int ai = 0; ai < 2; ++ai)
#pragma unroll
            for (int m = 0; m < 4; ++m) { const size_t r = (size_t)(row0 + ai * HALF + m * 16);
#pragma unroll
                for (int bj = 0; bj < 2; ++bj)
#pragma unroll
                    for (int n = 0; n < 2; ++n) { const size_t off = r * 1024 + col0 + bj * HALF + n * 16; *(f32x4*)(O + off) = *(const f32x4*)(X + off) + acc[ai][bj][m][n]; } }
    }
};

template <class Epi, class Sched, bool ALIGN_EPI = false, bool SP2 = false>
__device__ __forceinline__ void gemm_phase(PG8_LAS unsigned char* lds, const Gemm g, const Sched& S, const Epi& E) {
    const int tid = threadIdx.x, wid = __builtin_amdgcn_readfirstlane(tid >> 6), lane = tid & 63, wr = wid >> 2, wc = wid & 3, fr = lane & 15, fq = lane >> 4;
    const int K = g.K, nt = K / BK;
    unsigned voffA[2], voffB[2];
#pragma unroll
    for (int i = 0; i < 2; ++i) { int R, C; stage_rc(tid * 16 + i * 8192, R, C); const int Rb = Epi::PERM ? ((R & ~31) + perm32(R & 31)) : R;
        voffA[i] = (unsigned)(R * K + C) * 2u; voffB[i] = (unsigned)(Rb * K + C) * 2u; }
    const size_t kstep = (size_t)(BK * 2);
    const size_t hstep = (size_t)HALF * K * 2;
    const size_t tstep = 2 * hstep;
    const unsigned ldsw = (unsigned)wid * 1024u;
    const int aoff = lds_byte(wr * 64 + fr, fq * 8), boff = lds_byte(wc * 32 + fr, fq * 8);
#define PG8_SA(b, h) (((b) * 2 + (h)) * HTB)
#define PG8_SB(b, h) ((4 + (b) * 2 + (h)) * HTB)
#define PG8_STAGE(bufoff, gbase, voff) do { _Pragma("unroll") for (int _i = 0; _i < 2; ++_i) \
        __builtin_amdgcn_global_load_lds((const unsigned*)((const char*)(gbase) + (voff)[_i]), (PG8_LAS unsigned*)(lds + (bufoff) + ldsw + _i * 8192), 16, 0, 0); } while (0)
#define PG8_LDA(dst, b, h) do { _Pragma("unroll") for (int m = 0; m < 4; ++m) _Pragma("unroll") for (int k = 0; k < 2; ++k) dst[m][k] = *(const PG8_LAS bf16x8*)(lds + PG8_SA(b, h) + aoff + m * 2048 + k * 1024); } while (0)
#define PG8_LDB(dst, b, h) do { _Pragma("unroll") for (int n = 0; n < 2; ++n) _Pragma("unroll") for (int k = 0; k < 2; ++k) dst[n][k] = *(const PG8_LAS bf16x8*)(lds + PG8_SB(b, h) + boff + n * 2048 + k * 1024); } while (0)
#define PG8_MMA(ai, bj, At, Bt) do { __builtin_amdgcn_s_setprio(1); _Pragma("unroll") for (int m = 0; m < 4; ++m) _Pragma("unroll") for (int n = 0; n < 2; ++n) _Pragma("unroll") for (int k = 0; k < 2; ++k) \
        acc[ai][bj][m][n] = __builtin_amdgcn_mfma_f32_16x16x32_bf16(Bt[n][k], At[m][k], acc[ai][bj][m][n], 0, 0, 0); __builtin_amdgcn_s_setprio(0); } while (0)
#define PG8_WAIT_V(n) asm volatile("s_waitcnt vmcnt(" #n ")" ::: "memory")
#define PG8_WAIT_L(n) asm volatile("s_waitcnt lgkmcnt(" #n ")" ::: "memory")
#define PG8_BAR __builtin_amdgcn_s_barrier()
#define PG8_SCHED __builtin_amdgcn_sched_barrier(0)
    Unit cur, nxt; int ui = 0;
    if (!S.next(0, cur)) return;
    f32x4 acc[2][2][4][2];
#pragma unroll
    for (int a = 0; a < 2; ++a)
#pragma unroll
        for (int b = 0; b < 2; ++b)
#pragma unroll
            for (int m = 0; m < 4; ++m)
#pragma unroll
                for (int n = 0; n < 2; ++n) acc[a][b][m][n] = (f32x4){0.f, 0.f, 0.f, 0.f};
    bf16x8 At[4][2], B0[2][2], B1[2][2];
    const char* cA = (const char*)g.A + (size_t)cur.pm * tstep; const char* cB = (const char*)g.Bt + (size_t)cur.pn * tstep;
    S.a_ready(cur);
    if constexpr (SP2) {
        PG8_STAGE(PG8_SB(0, 0), cB, voffB); PG8_STAGE(PG8_SB(0, 1), cB + hstep, voffB); PG8_STAGE(PG8_SA(0, 0), cA, voffA); PG8_STAGE(PG8_SA(0, 1), cA + hstep, voffA);
        if (wr == 1) PG8_BAR;
        PG8_WAIT_V(2); PG8_BAR;
        PG8_STAGE(PG8_SB(1, 0), cB + kstep, voffB); PG8_STAGE(PG8_SA(1, 0), cA + kstep, voffA); PG8_STAGE(PG8_SB(1, 1), cB + hstep + kstep, voffB);
        PG8_WAIT_V(6); PG8_BAR;
    } else {
        PG8_STAGE(PG8_SB(0, 0), cB, voffB); PG8_STAGE(PG8_SA(0, 0), cA, voffA); PG8_STAGE(PG8_SB(0, 1), cB + hstep, voffB); PG8_STAGE(PG8_SA(0, 1), cA + hstep, voffA);
        if (wr == 1) PG8_BAR;
        PG8_WAIT_V(4); PG8_BAR;
        PG8_STAGE(PG8_SB(1, 0), cB + kstep, voffB); PG8_STAGE(PG8_SA(1, 0), cA + kstep, voffA); PG8_STAGE(PG8_SB(1, 1), cB + hstep + kstep, voffB);
        PG8_WAIT_V(6); PG8_BAR;
    }
    for (;;) {
        const bool has_next = S.next(ui + 1, nxt);
        const char* nA = has_next ? (const char*)g.A + (size_t)nxt.pm * tstep : cA; const char* nB = has_next ? (const char*)g.Bt + (size_t)nxt.pn * tstep : cB;
        for (int t = 0; t < nt; t += 2) {
            const bool last = (t == nt - 2);
            const char* a1 = cA + (size_t)(t + 1) * kstep;
            const char* a2 = last ? nA : cA + (size_t)(t + 2) * kstep; const char* b2 = last ? nB : cB + (size_t)(t + 2) * kstep;
            const char* a3 = a2 + kstep; const char* b3 = b2 + kstep;
            if (last && has_next) S.a_ready(nxt);
            if constexpr (SP2) {
            PG8_LDB(B0, 0, 0); PG8_LDB(B1, 0, 1); PG8_SCHED; PG8_LDA(At, 0, 0); PG8_STAGE(PG8_SA(1, 1), a1 + hstep, voffA);
            PG8_WAIT_V(8); PG8_WAIT_L(0); PG8_BAR; PG8_MMA(0, 0, At, B0); PG8_MMA(0, 1, At, B1); PG8_BAR; PG8_SCHED;
            PG8_LDA(At, 0, 1); PG8_STAGE(PG8_SB(0, 0), b2, voffB); PG8_STAGE(PG8_SB(0, 1), b2 + hstep, voffB); PG8_STAGE(PG8_SA(0, 0), a2, voffA);
            PG8_WAIT_V(8); PG8_WAIT_L(0); PG8_BAR; PG8_MMA(1, 0, At, B0); PG8_MMA(1, 1, At, B1); PG8_BAR; PG8_SCHED;
            PG8_LDB(B0, 1, 0); PG8_LDB(B1, 1, 1); PG8_SCHED; PG8_LDA(At, 1, 0); PG8_STAGE(PG8_SA(0, 1), a2 + hstep, voffA);
            PG8_WAIT_V(8); PG8_WAIT_L(0); PG8_BAR; PG8_MMA(0, 0, At, B0); PG8_MMA(0, 1, At, B1); PG8_BAR; PG8_SCHED;
            PG8_LDA(At, 1, 1); PG8_STAGE(PG8_SB(1, 0), b3, voffB); PG8_STAGE(PG8_SB(1, 1), b3 + hstep, voffB); PG8_STAGE(PG8_SA(1, 0), a3, voffA);
            PG8_WAIT_V(8); PG8_WAIT_L(0); PG8_BAR; PG8_MMA(1, 0, At, B0); PG8_MMA(1, 1, At, B1); PG8_BAR; PG8_SCHED;
            } else {
            PG8_LDB(B0, 0, 0); PG8_SCHED; PG8_LDA(At, 0, 0); PG8_STAGE(PG8_SA(1, 1), a1 + hstep, voffA);
            PG8_WAIT_L(8); PG8_BAR; PG8_WAIT_L(0); PG8_MMA(0, 0, At, B0); PG8_BAR; PG8_SCHED;
            PG8_LDB(B1, 0, 1); PG8_STAGE(PG8_SB(0, 0), b2, voffB);
            PG8_BAR; PG8_WAIT_L(0); PG8_MMA(0, 1, At, B1); PG8_BAR;
            PG8_LDA(At, 0, 1); PG8_STAGE(PG8_SA(0, 0), a2, voffA);
            PG8_BAR; PG8_WAIT_L(0); PG8_MMA(1, 0, At, B0); PG8_BAR; PG8_SCHED;
            PG8_STAGE(PG8_SB(0, 1), b2 + hstep, voffB);
            PG8_WAIT_V(6); PG8_BAR; PG8_MMA(1, 1, At, B1); PG8_BAR;
            PG8_LDB(B0, 1, 0); PG8_SCHED; PG8_LDA(At, 1, 0); PG8_STAGE(PG8_SA(0, 1), a2 + hstep, voffA);
            PG8_WAIT_L(8); PG8_BAR; PG8_WAIT_L(0); PG8_MMA(0, 0, At, B0); PG8_BAR; PG8_SCHED;
            PG8_LDB(B1, 1, 1); PG8_STAGE(PG8_SB(1, 0), b3, voffB);
            PG8_BAR; PG8_WAIT_L(0); PG8_MMA(0, 1, At, B1); PG8_BAR;
            PG8_LDA(At, 1, 1); PG8_STAGE(PG8_SA(1, 0), a3, voffA);
            PG8_BAR; PG8_WAIT_L(0); PG8_MMA(1, 0, At, B0); PG8_BAR; PG8_SCHED;
            PG8_STAGE(PG8_SB(1, 1), b3 + hstep, voffB);
            PG8_WAIT_V(6); PG8_BAR; PG8_MMA(1, 1, At, B1); PG8_BAR;
            }
        }
        if constexpr (ALIGN_EPI) { if (wr == 0) PG8_BAR; }
        if constexpr (!Epi::AFTER_DRAIN) { E(acc, cur, wr, wc, fr, fq); S.done(cur); }
        if (!has_next) break;
#pragma unroll
        for (int a = 0; a < 2; ++a)
#pragma unroll
            for (int b = 0; b < 2; ++b)
#pragma unroll
                for (int m = 0; m < 4; ++m)
#pragma unroll
                    for (int n = 0; n < 2; ++n) acc[a][b][m][n] = (f32x4){0.f, 0.f, 0.f, 0.f};
        cur = nxt; cA = nA; cB = nB; ++ui;
        if constexpr (ALIGN_EPI) { if (wr == 1) PG8_BAR; }
    }
    PG8_WAIT_V(0);
    if constexpr (!ALIGN_EPI) { if (wr == 0) PG8_BAR; }
    PG8_BAR;
    if constexpr (Epi::AFTER_DRAIN) { E.fused(acc, cur, wr, wc, fr, fq, lds, wid, lane); S.done(cur); }
#undef PG8_SA
#undef PG8_SB
#undef PG8_STAGE
#undef PG8_LDA
#undef PG8_LDB
#undef PG8_MMA
#undef PG8_WAIT_V
#undef PG8_WAIT_L
#undef PG8_BAR
#undef PG8_SCHED
}
}

constexpr int NWAVES = 8;
constexpr int BATCH = 4, SEQ = 8192, D = 1024, M = BATCH * SEQ;
constexpr int BW = 512, NQKV = 4608, N1 = 5120, N2 = 3072, INW = 8192, QKVP = 1536, NGH = 24, NKEY = 129, BIASP = 132;
constexpr float RMS_EPS = 1e-6f;
constexpr float LOG2E = 1.4426950408889634f;
constexpr float C2 = 0.125f * LOG2E;
#ifndef MK_ONE_LAUNCH
#define MK_ONE_LAUNCH 1
#endif
constexpr int NPHASE = 7;

constexpr size_t MiB = 1u << 20;
constexpr size_t WS_CTL = 0, CTL_ZERO_BYTES = 1 * MiB;
constexpr size_t WS_WT1 = 2 * MiB;
constexpr size_t WS_WT2 = 12 * MiB;
constexpr size_t WS_WAT = 18 * MiB, WS_WBT = 19 * MiB, WS_WOT = 20 * MiB;
constexpr size_t WS_BIAS = 22 * MiB;
constexpr size_t WS_LSE = 23 * MiB;
constexpr size_t WS_Q = 32 * MiB, WS_K = 128 * MiB, WS_V = 224 * MiB;
constexpr size_t WS_AP = 320 * MiB;
constexpr size_t WS_MIX = 352 * MiB;
constexpr size_t WS_XN = 384 * MiB;
constexpr size_t WS_UA = 128 * MiB, WS_UB = 160 * MiB, WS_G = 192 * MiB;
constexpr size_t WS_MRG = 320 * MiB;
constexpr size_t WS_END = 448 * MiB;
constexpr int CW_BAR = 4096;

constexpr int RING_OFF = 0, RING_BYTES = 131072;
constexpr int LDSCTL_OFF = 139264, MISC_OFF = LDSCTL_OFF + 320;
constexpr int LDS_BYTES = 147456;

static_assert(WS_V - WS_K == WS_K - WS_Q, "Q|K|V equally spaced");
#define GAS __attribute__((address_space(1)))
#define LAS __attribute__((address_space(3)))
typedef unsigned short bf16;
typedef unsigned v4u __attribute__((ext_vector_type(4)));
typedef float f32x4 __attribute__((ext_vector_type(4)));
typedef short bf16x8 __attribute__((ext_vector_type(8)));
typedef GAS unsigned gu32;
typedef GAS unsigned long long gu64;
#define RLX_AGENT __ATOMIC_RELAXED, __HIP_MEMORY_SCOPE_AGENT
#define LDS_WAIT() asm volatile("s_waitcnt lgkmcnt(0)" ::: "memory")
#define VM_WAIT() asm volatile("s_waitcnt vmcnt(0)" ::: "memory")
__device__ __forceinline__ unsigned long long rt() { return __builtin_amdgcn_s_memrealtime(); }
__device__ __forceinline__ unsigned f2bf(float f) { unsigned u = __builtin_bit_cast(unsigned, f); return (u + 0x7fffu + ((u >> 16) & 1u)) >> 16; }
__device__ __forceinline__ unsigned pk2(float lo, float hi) { return f2bf(lo) | (f2bf(hi) << 16); }

#define XB_TMO      128
#define XB_XCNT(j)  (256  + 64 * (j))
#define XB_XSUB(j)  (1280 + 64 * (j))
#define XB_XGEN(j)  (2304 + 64 * (j))
#define XB_TOP      3328
#define XB_TOPGEN   3392
#define XCD_BAR_WORDS 3456
#define XB_SPIN_CAP (1u << 18)

__device__ __forceinline__ unsigned xb_ld(unsigned* p)              { return __hip_atomic_load(p, __ATOMIC_RELAXED, __HIP_MEMORY_SCOPE_AGENT); }
__device__ __forceinline__ unsigned xb_add(unsigned* p, unsigned v) { return __hip_atomic_fetch_add(p, v, __ATOMIC_RELAXED, __HIP_MEMORY_SCOPE_AGENT); }
__device__ __forceinline__ unsigned xb_xcc_id() { return (unsigned)__builtin_amdgcn_s_getreg((3 << 11) | 20) & 0xFu; }
#define XB_SPIN(cond, bar) do { unsigned _sp = 0; while (cond) { __builtin_amdgcn_s_sleep(1); \
    if ((++_sp & 255u) == 0u) { if (xb_ld(&(bar)[XB_TMO])) break; if (_sp > XB_SPIN_CAP) { atomicAdd(&(bar)[XB_TMO], 1u); break; } } } } while (0)

struct XcdBarrier {
    unsigned* bar; unsigned x;
    volatile LAS unsigned* st;
};

__device__ __forceinline__ XcdBarrier xcd_barrier_post(unsigned* bar, volatile LAS unsigned* st) {
    XcdBarrier b; b.bar = bar; b.x = xb_xcc_id(); b.st = st;
    if (threadIdx.x == 0) (void)xb_add(&bar[XB_XCNT(b.x)], 1u);
    return b;
}
__device__ __forceinline__ void xcd_barrier_complete(unsigned* bar, unsigned x, unsigned& nloc, unsigned& nx) {
    const unsigned G = gridDim.x * gridDim.y * gridDim.z;
    unsigned sum, cnt, mine, sp = 0u;
    for (;;) {
        sum = 0u; cnt = 0u; mine = 0u;
#pragma unroll
        for (unsigned j = 0; j < 16; ++j) { const unsigned c = xb_ld(&bar[XB_XCNT(j)]); sum += c; cnt += (c > 0u) ? 1u : 0u; mine = (j == x) ? c : mine; }
        if (sum == G) break;
        __builtin_amdgcn_s_sleep(1);
        if ((++sp & 255u) == 0u) { if (xb_ld(&bar[XB_TMO])) break; if (sp > XB_SPIN_CAP) { atomicAdd(&bar[XB_TMO], 1u); break; } }
    }
    nloc = mine > 0u ? mine : 1u; nx = cnt > 0u ? cnt : 1u;
}

__device__ __forceinline__ void xcd_barrier(const XcdBarrier& b) {
    asm volatile("s_waitcnt vmcnt(0)" ::: "memory");
    __syncthreads();
    if (threadIdx.x == 0) {
        unsigned* bar = b.bar;
        __builtin_amdgcn_s_waitcnt(0);
        unsigned nloc = b.st[0], nx = b.st[1];
        if (nloc == 0u) { xcd_barrier_complete(bar, b.x, nloc, nx); b.st[0] = nloc; b.st[1] = nx; }
        const unsigned old = xb_add(&bar[XB_XSUB(b.x)], 1u);
        const unsigned gen = old / nloc;
        if (old + 1u == (gen + 1u) * nloc) {
            __builtin_amdgcn_fence(__ATOMIC_RELEASE, "agent");
            asm volatile("s_waitcnt vmcnt(0)" ::: "memory");
            const unsigned og = xb_add(&bar[XB_TOP], 1u);
            const unsigned tg = og / nx;
            if (og + 1u == (tg + 1u) * nx) xb_add(&bar[XB_TOPGEN], 1u);
            else XB_SPIN(xb_ld(&bar[XB_TOPGEN]) == tg, bar);
            __builtin_amdgcn_fence(__ATOMIC_ACQUIRE, "agent");
            xb_add(&bar[XB_XGEN(b.x)], 1u);
            asm volatile("s_waitcnt vmcnt(0)" ::: "memory");
        } else {
            XB_SPIN(xb_ld(&bar[XB_XGEN(b.x)]) == gen, bar);
            __builtin_amdgcn_fence(__ATOMIC_ACQUIRE, "agent");
            asm volatile("s_waitcnt vmcnt(0)" ::: "memory");
        }
    }
    __syncthreads();
}

struct Frame {
    LAS unsigned char* lds;
    int tid, lane, wave;
    int vcu, G;
    const float *x, *norm_gain, *w_in, *b_gate, *rel_bias, *w_pool, *pool_scale, *w_proj_a, *w_proj_b, *w_out, *final_gain;
    float* out;
    bf16 *Wt1, *Wt2, *Wat, *Wbt, *Wot;
    float *BIAS, *LSE;
    bf16 *Qb, *Kb, *Vb, *AP, *MIX, *XN, *UA, *UB, *GG, *MRG;
};
__device__ __forceinline__ float wave_sum(float v) {
#pragma unroll
    for (int o = 1; o < 64; o <<= 1) v += __shfl_xor(v, o);
    return v;
}
__device__ __forceinline__ float wave_max(float v) {
#pragma unroll
    for (int o = 1; o < 64; o <<= 1) v = fmaxf(v, __shfl_xor(v, o));
    return v;
}
__device__ __forceinline__ float bf2f(unsigned short b) { return __uint_as_float(((unsigned)b) << 16); }
__device__ __forceinline__ float blo(unsigned w) { return __uint_as_float(w << 16); }
__device__ __forceinline__ float bhi(unsigned w) { return __uint_as_float(w & 0xffff0000u); }

__device__ __forceinline__ void p0_transpose_item(const float* W, int ldw, int col0, int ncols, int K, const float* gain, bf16* WT, int row_off, LAS float* scr, int item, int lane) {
    const int nblk = ncols / 32, kb = item / nblk, nb = item % nblk, k0 = 64 * kb, n0 = 32 * nb;
#pragma unroll 8
    for (int i = 0; i < 32; ++i) { const int kk = 2 * i + (lane >> 5); float v = W[(size_t)(k0 + kk) * ldw + col0 + n0 + (lane & 31)]; if (gain) v *= gain[k0 + kk]; scr[kk * 33 + (lane & 31)] = v; }
    LDS_WAIT(); asm volatile("" ::: "memory");
    const int c = lane & 7;
#pragma unroll
    for (int j = 0; j < 4; ++j) { const int n = (lane >> 3) + 8 * j; const LAS float* s = scr + (8 * c) * 33 + n;
        v4u o; o.x = pk2(s[0 * 33], s[1 * 33]); o.y = pk2(s[2 * 33], s[3 * 33]); o.z = pk2(s[4 * 33], s[5 * 33]); o.w = pk2(s[6 * 33], s[7 * 33]);
        *(GAS v4u*)(WT + (size_t)(row_off + n0 + n) * K + k0 + 8 * c) = o; }
    LDS_WAIT(); asm volatile("" ::: "memory");
}
__device__ __forceinline__ void rms_row_to_bf16(const float* xrow, bf16* orow, int lane) {
    const GAS f32x4* xr = (const GAS f32x4*)xrow + lane;
    f32x4 v[4]; float s = 0.f;
#pragma unroll
    for (int j = 0; j < 4; ++j) { v[j] = xr[64 * j]; s += (v[j].x * v[j].x + v[j].y * v[j].y) + (v[j].z * v[j].z + v[j].w * v[j].w); }
    const float r = 1.0f / sqrtf(wave_sum(s) * (1.f / D) + RMS_EPS);
    GAS unsigned long long* o8 = (GAS unsigned long long*)orow + lane;
#pragma unroll
    for (int j = 0; j < 4; ++j) o8[64 * j] = (unsigned long long)pk2(v[j].x * r, v[j].y * r) | ((unsigned long long)pk2(v[j].z * r, v[j].w * r) << 32);
}
__device__ __forceinline__ int t5_bucket(int rel) {
    const int nb = 16, max_exact = 8;
    const int ret = (rel > 0) ? nb : 0;
    const int n = rel < 0 ? -rel : rel;
    const float nf = (float)(n > 1 ? n : 1);
    int large = max_exact + (int)(logf(nf / (float)max_exact) / logf(1024.0f / (float)max_exact) * (float)(nb - max_exact));
    large = large < nb - 1 ? large : nb - 1;
    return ret + (n < max_exact ? n : large);
}
__device__ __forceinline__ void p0_prologue(Frame& F) {
    {
        LAS float* tile = (LAS float*)(F.lds + RING_OFF);
        for (int task = F.vcu; task < 16 * 4 * 4; task += F.G) {
            const int kb = task >> 4, gp = (task >> 2) & 3, dq = task & 3;
            __syncthreads();
#pragma unroll
            for (int i = 0; i < 16; ++i) { const int e = F.tid + 512 * i, kk = e >> 7, c = e & 127; tile[kk * 129 + c] = F.w_in[(size_t)(kb * 64 + kk) * INW + gp * 128 + c]; }
            __syncthreads();
            const int k = kb * 64 + F.lane; float a[4] = {0.f, 0.f, 0.f, 0.f}; const int d0 = dq * 32 + F.wave * 4;
            const float* wp = F.w_pool + (size_t)gp * 16384 + d0;
            for (int c = 0; c < 128; ++c) { const float t = tile[F.lane * 129 + c];
#pragma unroll
                for (int i = 0; i < 4; ++i) a[i] += t * wp[c * 128 + i]; }
            const float gk = F.norm_gain[k];
#pragma unroll
            for (int i = 0; i < 4; ++i) { const int cp = gp * 128 + d0 + i; F.Wt1[(size_t)(NQKV + cp) * D + k] = (bf16)f2bf(a[i] * gk * F.pool_scale[cp]); }
        }
        __syncthreads();
    }
    LAS float* scr = (LAS float*)(F.lds + RING_OFF + F.wave * 16384);
    const int gw = F.vcu * NWAVES + F.wave, NGW = F.G * NWAVES;
    constexpr int I_QKV = (D / 64) * (NQKV / 32), I_AG = (D / 64) * (BW / 32), I_GL = (D / 64) * (2 * D / 32), I_PA = (BW / 64) * (D / 32), I_WO = (D / 64) * (D / 32);
    constexpr int NITEMS = I_QKV + 2 * I_AG + I_GL + 2 * I_PA + I_WO;
    for (int it = gw; it < NITEMS; it += NGW) {
        int r = it;
        if (r < I_QKV) { p0_transpose_item(F.w_in, INW, 1024, NQKV, D, F.norm_gain, F.Wt1, 0, scr, r, F.lane); continue; } r -= I_QKV;
        if (r < I_AG)  { p0_transpose_item(F.w_in, INW, 512, BW, D, F.norm_gain, F.Wt2, 0, scr, r, F.lane); continue; } r -= I_AG;
        if (r < I_AG)  { p0_transpose_item(F.w_in, INW, 5632, BW, D, F.norm_gain, F.Wt2, 512, scr, r, F.lane); continue; } r -= I_AG;
        if (r < I_GL)  { p0_transpose_item(F.w_in, INW, 6144, 2 * D, D, F.norm_gain, F.Wt2, 1024, scr, r, F.lane); continue; } r -= I_GL;
        if (r < I_PA)  { p0_transpose_item(F.w_proj_a, D, 0, D, BW, nullptr, F.Wat, 0, scr, r, F.lane); continue; } r -= I_PA;
        if (r < I_PA)  { p0_transpose_item(F.w_proj_b, D, 0, D, BW, nullptr, F.Wbt, 0, scr, r, F.lane); continue; } r -= I_PA;
        p0_transpose_item(F.w_out, D, 0, D, D, nullptr, F.Wot, 0, scr, r, F.lane);
    }
    for (int m = gw; m < M; m += NGW) rms_row_to_bf16(F.x + (size_t)m * D, F.XN + (size_t)m * D, F.lane);
    for (int idx = (int)blockIdx.x * 512 + F.tid; idx < NGH * BIASP; idx += F.G * 512) {
        const int gh = idx / BIASP, j = idx % BIASP, g = gh >> 3; const int dil = (g == 0) ? 1 : ((g == 1) ? 4 : 16);
        float v = 0.f; if (j < NKEY) v = F.rel_bias[t5_bucket((j - 64) * dil) * NGH + gh] * LOG2E;
        F.BIAS[idx] = v;
    }
}

__device__ __forceinline__ void p2_attention_simple(Frame& F) {
    LAS float* pbuf = (LAS float*)(F.lds + RING_OFF + F.wave * 1024);
    const int gw = F.vcu * NWAVES + F.wave, NGW = F.G * NWAVES, lane = F.lane;
    for (int task = gw; task < M * NGH; task += NGW) {
        const int t = task / NGH, gh = task - t * NGH, g = gh >> 3, h = gh & 7;
        const int pos = t & (SEQ - 1), dil = (g == 0) ? 1 : ((g == 1) ? 4 : 16);
        const size_t hoff = (size_t)g * 512 + h * 64;
        bf16* qrow = F.Qb + (size_t)t * QKVP + hoff;
        float q[64];
#pragma unroll
        for (int i = 0; i < 8; ++i) { const v4u w = *(const GAS v4u*)(qrow + 8 * i);
            q[8 * i + 0] = blo(w.x); q[8 * i + 1] = bhi(w.x); q[8 * i + 2] = blo(w.y); q[8 * i + 3] = bhi(w.y); q[8 * i + 4] = blo(w.z); q[8 * i + 5] = bhi(w.z); q[8 * i + 6] = blo(w.w); q[8 * i + 7] = bhi(w.w); }
        float s[3];
#pragma unroll
        for (int jj = 0; jj < 3; ++jj) {
            const int j = lane + 64 * jj, kpos = pos + (j - 64) * dil; const bool valid = (j < NKEY) && (kpos >= 0) && (kpos < SEQ);
            float dot = -INFINITY;
            if (valid) { const bf16* krow = F.Kb + (size_t)(t - pos + kpos) * QKVP + hoff; dot = 0.f;
#pragma unroll
                for (int i = 0; i < 8; ++i) { const v4u w = *(const GAS v4u*)(krow + 8 * i);
                    dot += q[8 * i + 0] * blo(w.x) + q[8 * i + 1] * bhi(w.x) + q[8 * i + 2] * blo(w.y) + q[8 * i + 3] * bhi(w.y) + q[8 * i + 4] * blo(w.z) + q[8 * i + 5] * bhi(w.z) + q[8 * i + 6] * blo(w.w) + q[8 * i + 7] * bhi(w.w); }
                dot += F.BIAS[gh * BIASP + j]; }
            s[jj] = dot;
        }
        const float mx = wave_max(fmaxf(fmaxf(s[0], s[1]), s[2]));
        float lsum = 0.f;
#pragma unroll
        for (int jj = 0; jj < 3; ++jj) { const float p = __builtin_amdgcn_exp2f(s[jj] - mx); pbuf[lane + 64 * jj] = p; lsum += p; }
        lsum = wave_sum(lsum);
        LDS_WAIT(); asm volatile("" ::: "memory");
        float o = 0.f;
        for (int j = 0; j < NKEY; ++j) { const int kpos = pos + (j - 64) * dil;
            if (kpos >= 0 && kpos < SEQ) o += pbuf[j] * bf2f(F.Vb[(size_t)(t - pos + kpos) * QKVP + hoff + lane]); }
        LDS_WAIT(); asm volatile("" ::: "memory");
        qrow[lane] = (bf16)f2bf(o / lsum);
        if (lane == 0) F.LSE[(size_t)t * NGH + gh] = mx + log2f(lsum);
    }
}
__device__ __forceinline__ void pool_acc(float (&a)[8], const v4u w, float s) {
    a[0] += s * blo(w.x); a[1] += s * bhi(w.x); a[2] += s * blo(w.y); a[3] += s * bhi(w.y); a[4] += s * blo(w.z); a[5] += s * bhi(w.z); a[6] += s * blo(w.w); a[7] += s * bhi(w.w);
}
__device__ __forceinline__ void p2_pool(Frame& F) {
    const int gw = F.vcu * NWAVES + F.wave, NGW = F.G * NWAVES, lane = F.lane;
    const int half = 1 << (lane >> 4);
    for (int task = gw; task < M / 16; task += NGW) {
        const int t0 = task * 16, pos0 = t0 & (SEQ - 1);
        const bf16* base = F.AP + (size_t)(t0 - pos0) * BW + lane * 8;
        float acc[8] = {0.f, 0.f, 0.f, 0.f, 0.f, 0.f, 0.f, 0.f}; float cnt = 0.f;
#pragma unroll
        for (int j = 0; j < 16; ++j) { const int row = pos0 - half + j; const bool valid = (j < 2 * half) && row >= 0 && row < SEQ; const int rc = row < 0 ? 0 : (row > SEQ - 1 ? SEQ - 1 : row);
            const v4u w = *(const GAS v4u*)(base + (size_t)rc * BW); const float s = valid ? 1.f : 0.f; pool_acc(acc, w, s); cnt += s; }
#pragma unroll
        for (int st = 0; st < 16; ++st) { const int pos = pos0 + st;
            const v4u cw = *(const GAS v4u*)(base + (size_t)pos * BW); const float ic = __builtin_amdgcn_rcpf(cnt);
            v4u o; o.x = pk2(acc[0] * ic - blo(cw.x), acc[1] * ic - bhi(cw.x)); o.y = pk2(acc[2] * ic - blo(cw.y), acc[3] * ic - bhi(cw.y));
            o.z = pk2(acc[4] * ic - blo(cw.z), acc[5] * ic - bhi(cw.z)); o.w = pk2(acc[6] * ic - blo(cw.w), acc[7] * ic - bhi(cw.w));
            *(GAS v4u*)(F.MIX + (size_t)(t0 + st) * BW + lane * 8) = o;
            const int ra = pos + half, rs = pos - half; const float sa = ra < SEQ ? 1.f : 0.f, ss = rs >= 0 ? 1.f : 0.f;
            const v4u wa = *(const GAS v4u*)(base + (size_t)(ra < SEQ ? ra : SEQ - 1) * BW), wsb = *(const GAS v4u*)(base + (size_t)(rs >= 0 ? rs : 0) * BW);
            pool_acc(acc, wa, sa); pool_acc(acc, wsb, -ss); cnt += sa - ss; }
    }
}
__device__ __forceinline__ void p6_final_norm(Frame& F) {
    const int gw = F.vcu * NWAVES + F.wave, NGW = F.G * NWAVES, lane = F.lane;
    f32x4 gn[4];
#pragma unroll
    for (int j = 0; j < 4; ++j) gn[j] = ((const GAS f32x4*)F.final_gain)[lane + 64 * j];
    for (int m = gw; m < M; m += NGW) {
        GAS f32x4* yr = (GAS f32x4*)(F.out + (size_t)m * D) + lane;
        f32x4 v[4]; float s = 0.f;
#pragma unroll
        for (int j = 0; j < 4; ++j) { v[j] = yr[64 * j]; s += (v[j].x * v[j].x + v[j].y * v[j].y) + (v[j].z * v[j].z + v[j].w * v[j].w); }
        const float r = 1.0f / sqrtf(wave_sum(s) * (1.f / D) + RMS_EPS);
#pragma unroll
        for (int j = 0; j < 4; ++j) yr[64 * j] = v[j] * r * gn[j];
    }
}


namespace att {
typedef short bf16x8 __attribute__((ext_vector_type(8)));
typedef short s16x4 __attribute__((ext_vector_type(4)));
typedef short v4i16_t __attribute__((ext_vector_type(4)));
typedef float f32x16 __attribute__((ext_vector_type(16)));
constexpr int KR = 384, L_K = 0, L_V = KR * 128, L_VH = KR * 64, L_T = 2 * KR * 128, L_WS = L_T + 4096, L_OST = L_WS + 8 * 256, L_END = L_OST + 8 * 4096;
constexpr int NUNITS = BATCH * 3 * 8 * 32;
__device__ __forceinline__ int crow(int r, int hi) { return (r & 3) + 8 * (r >> 2) + 4 * hi; }
__device__ __forceinline__ s16x4 vtr(const LAS unsigned char* p) { return __builtin_bit_cast(s16x4, __builtin_amdgcn_ds_read_tr16_b64_v4i16((LAS v4i16_t*)p)); }
}
__device__ __forceinline__ void p2_attention_mfma(Frame& F) {
    using namespace att;
    const int tid = F.tid, lane = F.lane, w = F.wave, r32 = lane & 31, hi = lane >> 5;
    LAS unsigned char* lds = F.lds;
    const int upw = (NUNITS + F.G - 1) / F.G;
    for (int ui = 0; ui < upw; ++ui) {
        const int u = F.vcu * upw + ui; if (u >= NUNITS) break;
        const int x = u & 31, h = (u >> 5) & 7, bg = u >> 8, g = bg % 3, b = bg / 3, gh = g * 8 + h;
        const int dil = (g == 0) ? 1 : ((g == 1) ? 4 : 16), SD = SEQ / dil;
        const int rres = (g == 0) ? 0 : ((g == 1) ? (x >> 3) : (x >> 1)), qt = (g == 0) ? x : ((g == 1) ? (x & 7) : (x & 1));
        const int i0 = qt * 256;
        const size_t rowbase = (size_t)b * SEQ + rres; const int hoff = g * 512 + h * 64;
        const size_t rstride = (size_t)dil * QKVP;
        __syncthreads();
        const bf16* Kg = F.Kb + rowbase * QKVP + hoff; const bf16* Vg = F.Vb + rowbase * QKVP + hoff;
#pragma unroll
        for (int j = 0; j < 6; ++j) { const int p = w + 8 * j, R = 8 * p + (lane >> 3); int i = i0 - 64 + R; i = i < 0 ? 0 : (i > SD - 1 ? SD - 1 : i);
            const int chunk = (lane & 7) ^ ((R >> 1) & 7);
            __builtin_amdgcn_global_load_lds((const unsigned*)(Kg + (size_t)i * rstride + chunk * 8), (LAS unsigned*)(lds + L_K + p * 1024), 16, 0, 0); }
#pragma unroll
        for (int j = 0; j < 6; ++j) { const int pp = w + 8 * j, dh = pp / 24, pv = pp - 24 * dh, R = 16 * pv + (lane >> 2); int i = i0 - 64 + R; i = i < 0 ? 0 : (i > SD - 1 ? SD - 1 : i);
            __builtin_amdgcn_global_load_lds((const unsigned*)(Vg + (size_t)i * rstride + dh * 32 + (lane & 3) * 8), (LAS unsigned*)(lds + L_V + dh * L_VH + pv * 1024), 16, 0, 0); }
#pragma unroll
        for (int k = 0; k < 2; ++k) { const int idx = tid + 512 * k, s = idx >> 8, n = idx & 255, j = n + s - 32;
            float v = -INFINITY; if (j >= 0 && j < NKEY) v = F.BIAS[gh * BIASP + j];
            ((LAS float*)(lds + L_T))[idx] = v; }
        const int iq = i0 + 32 * w + r32;
        bf16* Qrow = F.Qb + (rowbase + (size_t)iq * dil) * QKVP + hoff;
        bf16x8 qr[4];
#pragma unroll
        for (int kk = 0; kk < 4; ++kk) qr[kk] = *(const GAS bf16x8*)(Qrow + kk * 16 + hi * 8);
        asm volatile("s_waitcnt vmcnt(0) lgkmcnt(0)" ::: "memory");
        __syncthreads();
        f32x16 p[5];
        { const int s = (4 - (r32 & 3)) & 3; const LAS unsigned char* tb = lds + L_T + s * 1024 + (32 + 4 * hi - r32 - s) * 4;
#pragma unroll
          for (int kb = 0; kb < 5; ++kb) {
#pragma unroll
              for (int rr = 0; rr < 4; ++rr) { const f32x4 t4 = *(const LAS f32x4*)(tb + (32 * kb + 8 * rr) * 4); p[kb][4 * rr + 0] = t4[0]; p[kb][4 * rr + 1] = t4[1]; p[kb][4 * rr + 2] = t4[2]; p[kb][4 * rr + 3] = t4[3]; }
              const int R = 32 * w + 32 * kb + r32; const LAS unsigned char* kp = lds + L_K + R * 128; const int sw = (R >> 1) & 7;
#pragma unroll
              for (int kk = 0; kk < 4; ++kk) { const bf16x8 kf = *(const LAS bf16x8*)(kp + (((2 * kk + hi) ^ sw) << 4)); p[kb] = __builtin_amdgcn_mfma_f32_32x32x16_bf16(kf, qr[kk], p[kb], 0, 0, 0); }
          } }
        if (i0 == 0 || i0 + 256 == SD) {
#pragma unroll
            for (int kb = 0; kb < 5; ++kb)
#pragma unroll
                for (int r = 0; r < 16; ++r) { const int ki = i0 + 32 * w - 64 + 32 * kb + crow(r, hi); if (ki < 0 || ki >= SD) p[kb][r] = -INFINITY; }
        }
        float mx = p[0][0];
#pragma unroll
        for (int kb = 0; kb < 5; ++kb)
#pragma unroll
            for (int r = 0; r < 16; ++r) mx = fmaxf(mx, p[kb][r]);
        { auto rr = __builtin_amdgcn_permlane32_swap(__float_as_uint(mx), __float_as_uint(mx), false, false); mx = fmaxf(__uint_as_float(rr[0]), __uint_as_float(rr[1])); }
        float ls = 0.f;
#pragma unroll
        for (int kb = 0; kb < 5; ++kb)
#pragma unroll
            for (int r = 0; r < 16; ++r) { const float e = __builtin_amdgcn_exp2f(p[kb][r] - mx); p[kb][r] = e; ls += e; }
        { auto rr = __builtin_amdgcn_permlane32_swap(__float_as_uint(ls), __float_as_uint(ls), false, false); ls = __uint_as_float(rr[0]) + __uint_as_float(rr[1]); }
        f32x16 o[2]; o[0] = f32x16{}; o[1] = f32x16{};
        const LAS unsigned char* vb = lds + L_V + (32 * w + 4 * hi + ((lane & 15) >> 2)) * 64 + ((lane >> 4) & 1) * 32 + (lane & 3) * 8;
#pragma unroll
        for (int kb = 0; kb < 5; ++kb)
#pragma unroll
            for (int s = 0; s < 2; ++s) {
                v4u pw; pw.x = pg8::cvt_pk_bf16(p[kb][8 * s + 0], p[kb][8 * s + 1]); pw.y = pg8::cvt_pk_bf16(p[kb][8 * s + 2], p[kb][8 * s + 3]); pw.z = pg8::cvt_pk_bf16(p[kb][8 * s + 4], p[kb][8 * s + 5]); pw.w = pg8::cvt_pk_bf16(p[kb][8 * s + 6], p[kb][8 * s + 7]);
                const bf16x8 pa = __builtin_bit_cast(bf16x8, pw);
#pragma unroll
                for (int d0 = 0; d0 < 2; ++d0) { const LAS unsigned char* vp = vb + d0 * L_VH + (32 * kb + 16 * s) * 64;
                    const s16x4 lo = vtr(vp), hh = vtr(vp + 512);
                    const bf16x8 vf = (bf16x8){lo[0], lo[1], lo[2], lo[3], hh[0], hh[1], hh[2], hh[3]};
                    o[d0] = __builtin_amdgcn_mfma_f32_32x32x16_bf16(pa, vf, o[d0], 0, 0, 0); }
            }
        LAS float* wsf = (LAS float*)(lds + L_WS + w * 256);
        if (hi == 0) { wsf[r32] = __builtin_amdgcn_rcpf(ls); F.LSE[(rowbase + (size_t)iq * dil) * NGH + gh] = mx + __builtin_amdgcn_logf(ls); }
        asm volatile("s_waitcnt lgkmcnt(0)" ::: "memory");
        LAS unsigned short* stg = (LAS unsigned short*)(lds + L_OST + w * 4096);
#pragma unroll
        for (int r = 0; r < 16; ++r) { const int orow = crow(r, hi); const float rl = wsf[orow];
#pragma unroll
            for (int d0 = 0; d0 < 2; ++d0) stg[orow * 64 + d0 * 32 + r32] = (unsigned short)f2bf(o[d0][r] * rl); }
        asm volatile("s_waitcnt lgkmcnt(0)" ::: "memory");
#pragma unroll
        for (int i = 0; i < 4; ++i) { const int row = i * 8 + (lane >> 3), ch = lane & 7; const v4u v = *(const LAS v4u*)(stg + row * 64 + ch * 8);
            *(GAS v4u*)(F.Qb + (rowbase + (size_t)(i0 + 32 * w + row) * dil) * QKVP + hoff + ch * 8) = v; }
    }
}
static_assert(att::L_END <= LDSCTL_OFF, "attention scratch vs LDS control words");

#ifndef PROGRAM
#define PROGRAM X(0) X(1) X(2) X(3) X(4) X(5) X(6)
#endif
template <int PH> __device__ __forceinline__ void run_phase(Frame& F) {
    if constexpr (PH == 0) { p0_prologue(F); }
    else if constexpr (PH == 1) {
        pg8::Gemm g{F.XN, F.Wt1, M, N1, D}; pg8::StaticOrder S; S.init(M, N1, F.G, (int)blockIdx.x);
        pg8::EpiP1 E{F.Qb, (size_t)(WS_K - WS_Q) / 2, F.AP, C2};
        pg8::gemm_phase<pg8::EpiP1, pg8::StaticOrder, true, true>(F.lds + RING_OFF, g, S, E);
    } else if constexpr (PH == 2) { p2_attention_mfma(F); p2_pool(F); }
    else if constexpr (PH == 3) {
        pg8::Gemm g{F.XN, F.Wt2, M, N2, D}; pg8::StaticOrder S; S.init(M, N2, F.G, (int)blockIdx.x);
        pg8::EpiP3 E{F.MIX, F.Qb, F.LSE, F.b_gate, F.UA, F.UB, F.GG};
        pg8::gemm_phase<pg8::EpiP3, pg8::StaticOrder, true, true>(F.lds + RING_OFF, g, S, E);
    } else if constexpr (PH == 4) {
        { pg8::Gemm g{F.UA, F.Wat, M, D, BW}; pg8::StaticOrder S; S.init(M, D, F.G, (int)blockIdx.x);
          pg8::EpiP4<false> E{F.GG, F.MRG};
          pg8::gemm_phase<pg8::EpiP4<false>, pg8::StaticOrder, true, true>(F.lds + RING_OFF, g, S, E); }
        { pg8::Gemm g{F.UB, F.Wbt, M, D, BW}; pg8::StaticOrder S; S.init(M, D, F.G, (int)blockIdx.x);
          pg8::EpiP4<true> E{F.GG, F.MRG};
          pg8::gemm_phase<pg8::EpiP4<true>, pg8::StaticOrder, true, true>(F.lds + RING_OFF, g, S, E); }
    } else if constexpr (PH == 5) {
        pg8::Gemm g{F.MRG, F.Wot, M, D, D}; pg8::StaticOrder S; S.init(M, D, F.G, (int)blockIdx.x);
        pg8::EpiP5 E{F.x, F.out};
        pg8::gemm_phase<pg8::EpiP5, pg8::StaticOrder, true, true>(F.lds + RING_OFF, g, S, E);
    } else if constexpr (PH == 6) { p6_final_norm(F); }
}
struct Args { const float* in[11]; float* out; unsigned char* ws; };
__global__ void __launch_bounds__(NWAVES * 64, 2) skel_fwd(Args args) {
    extern __shared__ __attribute__((aligned(16))) unsigned char lds[];
    Frame F;
    F.lds = (LAS unsigned char*)lds;
    F.tid = threadIdx.x; F.lane = F.tid & 63; F.wave = __builtin_amdgcn_readfirstlane(F.tid >> 6);
    F.G = gridDim.x; { const int bx = blockIdx.x; F.vcu = (F.G % 8 == 0) ? (bx % 8) * (F.G / 8) + bx / 8 : bx; }
    unsigned char* ws = args.ws;
    F.x = args.in[0]; F.norm_gain = args.in[1]; F.w_in = args.in[2]; F.b_gate = args.in[3]; F.rel_bias = args.in[4]; F.w_pool = args.in[5]; F.pool_scale = args.in[6];
    F.w_proj_a = args.in[7]; F.w_proj_b = args.in[8]; F.w_out = args.in[9]; F.final_gain = args.in[10]; F.out = args.out;
    F.Wt1 = (bf16*)(ws + WS_WT1); F.Wt2 = (bf16*)(ws + WS_WT2); F.Wat = (bf16*)(ws + WS_WAT); F.Wbt = (bf16*)(ws + WS_WBT); F.Wot = (bf16*)(ws + WS_WOT);
    F.BIAS = (float*)(ws + WS_BIAS); F.LSE = (float*)(ws + WS_LSE);
    F.Qb = (bf16*)(ws + WS_Q); F.Kb = (bf16*)(ws + WS_K); F.Vb = (bf16*)(ws + WS_V); F.AP = (bf16*)(ws + WS_AP); F.MIX = (bf16*)(ws + WS_MIX); F.XN = (bf16*)(ws + WS_XN);
    F.UA = (bf16*)(ws + WS_UA); F.UB = (bf16*)(ws + WS_UB); F.GG = (bf16*)(ws + WS_G); F.MRG = (bf16*)(ws + WS_MRG);
    for (int u = F.tid; u < (LDS_BYTES - LDSCTL_OFF) / 4; u += NWAVES * 64) ((LAS unsigned*)(F.lds + LDSCTL_OFF))[u] = 0u;
    __syncthreads();
    XcdBarrier bar = xcd_barrier_post((unsigned*)(ws + WS_CTL) + CW_BAR, (volatile LAS unsigned*)(F.lds + MISC_OFF) + 8);
    bool first = true;
#define X(k) { if (!first) xcd_barrier(bar); first = false; run_phase<k>(F); }
    PROGRAM
#undef X
}

extern "C" void kernel_launch(void* const* d_in, const int* in_sizes, int n_in, void* d_out, int out_size, void* d_ws, size_t ws_size, hipStream_t stream) {
    static int grid = 0;
    if (grid == 0) {
        if (n_in != 11 || in_sizes[0] != M * D || out_size != M * D || ws_size < WS_END) { fprintf(stderr, "kernel_launch: unexpected shapes (n_in %d, in0 %d, out %d, ws %zu); nothing launched\n", n_in, n_in > 0 ? in_sizes[0] : -1, out_size, ws_size); grid = -1; return; }
        int dev = 0, cus = 0, per_cu = 0;
        if (hipGetDevice(&dev) != hipSuccess || hipDeviceGetAttribute(&cus, hipDeviceAttributeMultiprocessorCount, dev) != hipSuccess) { grid = -1; return; }
        if (hipFuncSetAttribute((const void*)skel_fwd, hipFuncAttributeMaxDynamicSharedMemorySize, LDS_BYTES) != hipSuccess) { fprintf(stderr, "kernel_launch: hipFuncSetAttribute failed\n"); grid = -1; return; }
        if (hipOccupancyMaxActiveBlocksPerMultiprocessor(&per_cu, (const void*)skel_fwd, NWAVES * 64, LDS_BYTES) != hipSuccess || per_cu < 1) { fprintf(stderr, "kernel_launch: occupancy query reports %d\n", per_cu); }
        (void)hipGetLastError();
        grid = cus;
    }
    if (grid < 0) return;
    if (hipMemsetAsync((char*)d_ws + WS_CTL, 0, CTL_ZERO_BYTES, stream) != hipSuccess) return;
    Args a{};
    for (int i = 0; i < 11; ++i) a.in[i] = (const float*)d_in[i];
    a.out = (float*)d_out; a.ws = (unsigned char*)d_ws;
    hipLaunchKernelGGL(skel_fwd, dim3(grid), dim3(NWAVES * 64), LDS_BYTES, stream, a);
}
```
